# Optimizing an MI355X kernel written in HIP

```python
import jax
import jax.numpy as jnp
from jax import lax
import numpy as np

D_MODEL = 2048
BATCH = 2
SEQ = 8192
DEPTH = 2

GRID_W = 64
CTX_LEN = 256
HEAD_DIM = 64
ATTN_SCALE = HEAD_DIM ** -0.5
EPS = 1e-6
NEG_INF = -1e30

D_MIX = D_MODEL
GROUP_W = D_MIX // 4

NA_HEADS = GROUP_W // HEAD_DIM
NA_KH = 8
NA_KW = 16

N_POOL = 4
POOL_WINDOWS = (2, 4, 8, 16)
POOL_CH = GROUP_W // N_POOL

CONV_W = 3

SWA_HEADS = GROUP_W // HEAD_DIM
SWA_KV_HEADS = 2
SWA_GROUP = SWA_HEADS // SWA_KV_HEADS
SWA_WINDOW = 128
SWA_BLOCK = 128
ROPE_BASE = 10000.0

D_FF = 7 * D_MODEL // 2
N_EXPERTS = 8
TOP_K = 2
N_DENSE = (DEPTH + 1) // 2
N_MOE = DEPTH // 2

KV_W = SWA_KV_HEADS * HEAD_DIM
IN_WIDTHS = (GROUP_W, GROUP_W, GROUP_W, GROUP_W, GROUP_W, GROUP_W, GROUP_W, GROUP_W, KV_W, KV_W)
D_IN = sum(IN_WIDTHS)
SPLIT_POINTS = tuple(sum(IN_WIDTHS[:i + 1]) for i in range(len(IN_WIDTHS) - 1))

kernel_name = "hybrid_parallel_heads_dit_block"


def rms_norm(x, g):
    xf = x.astype(jnp.float32)
    y = xf * lax.rsqrt(jnp.mean(xf * xf, axis=-1, keepdims=True) + EPS)
    return (y * g.astype(jnp.float32)).astype(x.dtype)


def modulate(h, shift, scale):
    return h * (1 + scale) + shift


def heads(t, n):
    b, m, _ = t.shape
    return t.reshape(b, m, n, HEAD_DIM).transpose(0, 2, 1, 3)


def merge_heads(o):
    b, h, m, d = o.shape
    return o.transpose(0, 2, 1, 3).reshape(b, m, h * d)


def gqa_heads(t):
    b, m, _ = t.shape
    return t.reshape(b, m, SWA_KV_HEADS, SWA_GROUP, HEAD_DIM).transpose(0, 2, 3, 1, 4)


def merge_gqa(o):
    b, k, g, m, d = o.shape
    return o.transpose(0, 3, 1, 2, 4).reshape(b, m, k * g * d)


def axial_rope(n):
    t = jnp.arange(n, dtype=jnp.int32)
    rows = (t // GRID_W).astype(jnp.float32)
    cols = (t % GRID_W).astype(jnp.float32)
    nf = HEAD_DIM // 4
    inv = ROPE_BASE ** (-jnp.arange(nf, dtype=jnp.float32) / nf)
    ang = jnp.concatenate([rows[:, None] * inv, cols[:, None] * inv], axis=-1)
    return jnp.cos(ang), jnp.sin(ang)


def apply_rope(x, cos, sin):
    half = HEAD_DIM // 2
    x1 = x[..., :half].astype(jnp.float32)
    x2 = x[..., half:].astype(jnp.float32)
    return jnp.concatenate([x1 * cos - x2 * sin, x1 * sin + x2 * cos], axis=-1).astype(x.dtype)


def ctx_attention(q, k, v, sink):
    s = jnp.einsum("bkgqd,bkld->bkgql", q, k).astype(jnp.float32) * ATTN_SCALE
    if sink is None:
        p = jax.nn.softmax(s, axis=-1)
    else:
        s_sink = jnp.broadcast_to(sink.astype(jnp.float32)[None, :, :, None, None], s.shape[:-1] + (1,))
        p = jax.nn.softmax(jnp.concatenate([s, s_sink], axis=-1), axis=-1)[..., :-1]
    return jnp.einsum("bkgql,bkld->bkgqd", p.astype(v.dtype), v)


def neighbourhood_attention(q, k, v, kc, vc, rpb):
    b, h, s, d = q.shape
    rows = s // GRID_W
    kh = min(NA_KH, rows)
    r = jnp.arange(rows)
    r0 = jnp.clip(r - kh // 2, 0, rows - kh)
    key_rows = r0[:, None] + jnp.arange(kh)[None, :]
    kg = k.reshape(b, h, rows, GRID_W, d)[:, :, key_rows]
    vg = v.reshape(b, h, rows, GRID_W, d)[:, :, key_rows]
    qg = q.reshape(b, h, rows, GRID_W, d)
    s_loc = jnp.einsum("bhrqd,bhrkwd->bhrqkw", qg, kg).astype(jnp.float32) * ATTN_SCALE
    col = jnp.arange(GRID_W)
    c0 = jnp.clip(col - NA_KW // 2, 0, GRID_W - NA_KW)
    col_mask = (col[None, :] >= c0[:, None]) & (col[None, :] < c0[:, None] + NA_KW)
    dr = key_rows - r[:, None] + (NA_KH - 1)
    dc = jnp.clip(col[None, :] - col[:, None], -(NA_KW - 1), NA_KW - 1) + (NA_KW - 1)
    bias = rpb.astype(jnp.float32)[:, dr[:, None, :, None], dc[None, :, None, :]]
    s_loc = jnp.where(col_mask[None, None, None, :, None, :], s_loc + bias[None], NEG_INF)
    s_loc = s_loc.reshape(b, h, rows, GRID_W, kh * GRID_W)
    s_ctx = jnp.einsum("bhrqd,bhld->bhrql", qg, kc).astype(jnp.float32) * ATTN_SCALE
    p = jax.nn.softmax(jnp.concatenate([s_loc, s_ctx], axis=-1), axis=-1).astype(v.dtype)
    n_loc = kh * GRID_W
    out = jnp.einsum("bhrqn,bhrnd->bhrqd", p[..., :n_loc], vg.reshape(b, h, rows, n_loc, d))
    out = out + jnp.einsum("bhrql,bhld->bhrqd", p[..., n_loc:], vc)
    return out.reshape(b, h, s, d)


def window_attention(q, k, v, kc, vc, sink):
    b, hk, g, s, d = q.shape
    nb = s // SWA_BLOCK
    pad = ((0, 0), (0, 0), (SWA_BLOCK, SWA_BLOCK), (0, 0))
    kp = jnp.pad(k, pad).reshape(b, hk, nb + 2, SWA_BLOCK, d)
    vp = jnp.pad(v, pad).reshape(b, hk, nb + 2, SWA_BLOCK, d)
    kb = jnp.concatenate([kp[:, :, :-2], kp[:, :, 1:-1], kp[:, :, 2:]], axis=3)
    vb = jnp.concatenate([vp[:, :, :-2], vp[:, :, 1:-1], vp[:, :, 2:]], axis=3)
    qb = q.reshape(b, hk, g, nb, SWA_BLOCK, d)
    s_loc = jnp.einsum("bkgnqd,bknjd->bkgnqj", qb, kb).astype(jnp.float32) * ATTN_SCALE
    blk = jnp.arange(nb)[:, None] * SWA_BLOCK
    qpos = blk + jnp.arange(SWA_BLOCK)[None, :]
    kpos = blk - SWA_BLOCK + jnp.arange(3 * SWA_BLOCK)[None, :]
    valid = (jnp.abs(qpos[:, :, None] - kpos[:, None, :]) <= SWA_WINDOW) & (kpos[:, None, :] >= 0) & (kpos[:, None, :] < s)
    s_loc = jnp.where(valid[None, None, None], s_loc, NEG_INF)
    s_ctx = jnp.einsum("bkgnqd,bkld->bkgnql", qb, kc).astype(jnp.float32) * ATTN_SCALE
    s_sink = jnp.broadcast_to(sink.astype(jnp.float32)[None, :, :, None, None, None], s_loc.shape[:-1] + (1,))
    p = jax.nn.softmax(jnp.concatenate([s_loc, s_ctx, s_sink], axis=-1), axis=-1).astype(v.dtype)
    n_loc = 3 * SWA_BLOCK
    n_ctx = kc.shape[2]
    out = jnp.einsum("bkgnqj,bknjd->bkgnqd", p[..., :n_loc], vb)
    out = out + jnp.einsum("bkgnql,bkld->bkgnqd", p[..., n_loc:n_loc + n_ctx], vc)
    return out.reshape(b, hk, g, s, d)


def multiscale_pool(u, pool_w, pool_scale):
    b, n, _ = u.shape
    uf = u.astype(jnp.float32)
    cs = jnp.pad(jnp.cumsum(uf, axis=1), ((0, 0), (1, 0), (0, 0)))
    t = jnp.arange(n)
    outs = []
    for gi, w in enumerate(POOL_WINDOWS):
        sl = slice(gi * POOL_CH, (gi + 1) * POOL_CH)
        lo = jnp.clip(t - w // 2, 0, n)
        hi = jnp.clip(t + w - w // 2, 0, n)
        cnt = (hi - lo).astype(jnp.float32)[None, :, None]
        mean = (cs[:, hi, sl] - cs[:, lo, sl]) / cnt
        outs.append(mean - uf[..., sl])
    pooled = jnp.concatenate(outs, axis=-1).astype(u.dtype).reshape(b, n, N_POOL, POOL_CH)
    y = jnp.einsum("bngc,gcd->bngd", pooled, pool_w).reshape(b, n, GROUP_W)
    return y * pool_scale


def short_conv_mixer(gate_b, gate_c, xv, conv_w):
    u = gate_c * xv
    n = u.shape[1]
    pad = CONV_W // 2
    up = jnp.pad(u, ((0, 0), (pad, pad), (0, 0)))
    y = sum(up[:, j:j + n] * conv_w[j] for j in range(CONV_W))
    return gate_b * y


def mixing_sublayer(h, hc, w_in, w_out, rpb, pool_w, pool_scale, conv_w, sink, cos, sin, ctx_out):
    qa, ka, va, ub, gb, gc, xv, qd, kd, vd = jnp.split(h @ w_in, SPLIT_POINTS, axis=-1)
    qac, kac, vac, ubc, gbc, gcc, xvc, qdc, kdc, vdc = jnp.split(hc @ w_in, SPLIT_POINTS, axis=-1)
    kac_h, vac_h = heads(kac, NA_HEADS), heads(vac, NA_HEADS)
    kdc_h, vdc_h = heads(kdc, SWA_KV_HEADS), heads(vdc, SWA_KV_HEADS)
    o_a = neighbourhood_attention(heads(qa, NA_HEADS), heads(ka, NA_HEADS), heads(va, NA_HEADS), kac_h, vac_h, rpb)
    o_b = multiscale_pool(ub, pool_w, pool_scale)
    o_c = short_conv_mixer(gb, gc, xv, conv_w)
    o_d = window_attention(apply_rope(gqa_heads(qd), cos, sin), apply_rope(heads(kd, SWA_KV_HEADS), cos, sin),
                           heads(vd, SWA_KV_HEADS), kdc_h, vdc_h, sink)
    y = jnp.concatenate([merge_heads(o_a), o_b, o_c, merge_gqa(o_d)], axis=-1) @ w_out
    if not ctx_out:
        return y, None
    oc_a = ctx_attention(heads(qac, NA_HEADS)[:, :, None], kac_h, vac_h, None)[:, :, 0]
    oc_b = multiscale_pool(ubc, pool_w, pool_scale)
    oc_c = short_conv_mixer(gbc, gcc, xvc, conv_w)
    oc_d = ctx_attention(gqa_heads(qdc), kdc_h, vdc_h, sink)
    yc = jnp.concatenate([merge_heads(oc_a), oc_b, oc_c, merge_gqa(oc_d)], axis=-1) @ w_out
    return y, yc


def swiglu(h, w_gate, w_up, w_down):
    return (jax.nn.silu(h @ w_gate) * (h @ w_up)) @ w_down


def moe_swiglu(h, router, w_gate, w_up, w_down):
    logits = (h @ router).astype(jnp.float32)
    top_val, top_idx = lax.top_k(logits, TOP_K)
    top_p = jax.nn.softmax(top_val, axis=-1)
    gate = jnp.einsum("bnk,bnke->bne", top_p, jax.nn.one_hot(top_idx, N_EXPERTS, dtype=jnp.float32)).astype(h.dtype)
    out = jnp.zeros_like(h)
    for e in range(N_EXPERTS):
        out = out + gate[..., e:e + 1] * swiglu(h, w_gate[e], w_up[e], w_down[e])
    return out


def setup_inputs(seed: int = 0) -> dict:
    key = jax.random.key(seed)
    ks = jax.random.split(key, 24)

    def nrm(k, shape, s):
        return jax.random.normal(k, shape, jnp.float32) * s

    return {
        "x": nrm(ks[0], (BATCH, SEQ, D_MODEL), 1.0),
        "c": nrm(ks[1], (BATCH, D_MODEL), 1.0),
        "ctx": nrm(ks[2], (BATCH, CTX_LEN, D_MODEL), 1.0),
        "c_ctx": nrm(ks[3], (D_MODEL,), 1.0),
        "w_ada": nrm(ks[4], (DEPTH, D_MODEL, 6 * D_MODEL), 0.5 * D_MODEL ** -0.5),
        "b_ada": nrm(ks[5], (DEPTH, 6 * D_MODEL), 0.02),
        "norm_mix": 1.0 + nrm(ks[6], (DEPTH, D_MODEL), 0.1),
        "norm_ffn": 1.0 + nrm(ks[7], (DEPTH, D_MODEL), 0.1),
        "norm_final": 1.0 + nrm(ks[8], (D_MODEL,), 0.1),
        "w_in": nrm(ks[9], (DEPTH, D_MODEL, D_IN), D_MODEL ** -0.5),
        "w_out": nrm(ks[10], (DEPTH, D_MIX, D_MODEL), D_MIX ** -0.5),
        "na_rpb": nrm(ks[11], (DEPTH, NA_HEADS, 2 * NA_KH - 1, 2 * NA_KW - 1), 0.5),
        "pool_w": nrm(ks[12], (DEPTH, N_POOL, POOL_CH, POOL_CH), POOL_CH ** -0.5),
        "pool_scale": 1.0 + nrm(ks[13], (DEPTH, GROUP_W), 0.1),
        "conv_w": nrm(ks[14], (DEPTH, CONV_W, GROUP_W), CONV_W ** -0.5),
        "swa_sink": nrm(ks[15], (DEPTH, SWA_KV_HEADS, SWA_GROUP), 1.0),
        "ffn_w_gate": nrm(ks[16], (N_DENSE, D_MODEL, D_FF), D_MODEL ** -0.5),
        "ffn_w_up": nrm(ks[17], (N_DENSE, D_MODEL, D_FF), D_MODEL ** -0.5),
        "ffn_w_down": nrm(ks[18], (N_DENSE, D_FF, D_MODEL), D_FF ** -0.5),
        "moe_router": nrm(ks[19], (N_MOE, D_MODEL, N_EXPERTS), D_MODEL ** -0.5),
        "moe_w_gate": nrm(ks[20], (N_MOE, N_EXPERTS, D_MODEL, D_FF), D_MODEL ** -0.5),
        "moe_w_up": nrm(ks[21], (N_MOE, N_EXPERTS, D_MODEL, D_FF), D_MODEL ** -0.5),
        "moe_w_down": nrm(ks[22], (N_MOE, N_EXPERTS, D_FF, D_MODEL), D_FF ** -0.5),
    }


def reference(x, c, ctx, c_ctx, w_ada, b_ada, norm_mix, norm_ffn, norm_final, w_in, w_out, na_rpb,
              pool_w, pool_scale, conv_w, swa_sink, ffn_w_gate, ffn_w_up, ffn_w_down,
              moe_router, moe_w_gate, moe_w_up, moe_w_down):
    n_ctx = ctx.shape[1]
    cos, sin = axial_rope(x.shape[1])
    cx = ctx
    for i in range(DEPTH):
        last = i == DEPTH - 1
        mod_x = (jax.nn.silu(c) @ w_ada[i] + b_ada[i])[:, None, :]
        mod_c = (jax.nn.silu(c_ctx) @ w_ada[i] + b_ada[i])[None, None, :]
        sh1, sc1, g1, sh2, sc2, g2 = jnp.split(mod_x, 6, axis=-1)
        csh1, csc1, cg1, csh2, csc2, cg2 = jnp.split(mod_c, 6, axis=-1)
        h = modulate(rms_norm(x, norm_mix[i]), sh1, sc1)
        hc = modulate(rms_norm(cx, norm_mix[i]), csh1, csc1)
        y, yc = mixing_sublayer(h, hc, w_in[i], w_out[i], na_rpb[i], pool_w[i], pool_scale[i], conv_w[i],
                                swa_sink[i], cos, sin, not last)
        x = x + g1 * y
        h = modulate(rms_norm(x, norm_ffn[i]), sh2, sc2)
        if not last:
            cx = cx + cg1 * yc
            hc = modulate(rms_norm(cx, norm_ffn[i]), csh2, csc2)
            h = jnp.concatenate([hc, h], axis=1)
        if i % 2 == 0:
            f = swiglu(h, ffn_w_gate[i // 2], ffn_w_up[i // 2], ffn_w_down[i // 2])
        else:
            f = moe_swiglu(h, moe_router[i // 2], moe_w_gate[i // 2], moe_w_up[i // 2], moe_w_down[i // 2])
        if not last:
            cx = cx + cg2 * f[:, :n_ctx]
            f = f[:, n_ctx:]
        x = x + g2 * f
    return rms_norm(x, norm_final)
```

```cpp
#include <hip/hip_runtime.h>
#include <cstdio>
#include <cstdint>

#define LAS __attribute__((address_space(3)))
#define GAS __attribute__((address_space(1)))
typedef unsigned short bf16_t;
typedef short bf16x8 __attribute__((ext_vector_type(8)));
typedef short s16x4 __attribute__((ext_vector_type(4)));
typedef float f32x4 __attribute__((ext_vector_type(4)));
typedef float f32x2 __attribute__((ext_vector_type(2)));
typedef unsigned u32x4 __attribute__((ext_vector_type(4)));
typedef unsigned u32x2 __attribute__((ext_vector_type(2)));

constexpr int DM = 2048, NB = 2, SEQ = 8192, CTXL = 256, GRW = 64, GRH = 128, HD = 64;
constexpr int RPB = CTXL + SEQ;
constexpr int MROWS = NB * RPB;
constexpr int NPAN = MROWS / 256;
constexpr int DIN = 4352, DFF = 7168, NGU = 2 * DFF;
constexpr int NEXP = 8, NTOK = NB * SEQ;
constexpr int MAXSLOT = 2 * NTOK + NEXP * 256, MAXTILES = MAXSLOT / 256;
constexpr int C_QA = 0, C_KA = 512, C_VA = 1024, C_UB = 1536, C_GB = 2048, C_GC = 2560, C_XV = 3072, C_QD = 3584, C_KD = 4096, C_VD = 4224;
constexpr float EPS = 1e-6f;
constexpr float LOG2E = 1.4426950408889634f;
constexpr float QSCALE = 0.125f * LOG2E;

constexpr size_t MiB = 1u << 20;
constexpr size_t WS_CTL = 0, CTL_ZERO_BYTES = 1 * MiB;
constexpr size_t WS_MOD = 1 * MiB;
constexpr size_t WS_ROPE = 1 * MiB + 512 * 1024;
constexpr size_t WS_ROUTE = 2 * MiB;
constexpr size_t WS_SLOTS = 1 * MiB + 768 * 1024;
constexpr size_t WS_TAILF = 2 * MiB + 384 * 1024;
constexpr size_t WS_CNT = 2 * MiB + 512 * 1024;
constexpr size_t WS_ROWTOK = 3 * MiB;
constexpr size_t WS_ROWDST = 3 * MiB + 256 * 1024;
constexpr size_t WS_ROWP = 3 * MiB + 512 * 1024;
constexpr size_t WS_TILES = 3 * MiB + 768 * 1024;
constexpr size_t WS_WIN = 4 * MiB;
constexpr size_t SZ_WIN = (size_t)DIN * DM * 2;
constexpr size_t WS_WOUT = WS_WIN + 2 * SZ_WIN;
constexpr size_t SZ_WOUT = (size_t)DM * DM * 2;
constexpr size_t WS_WGU = WS_WOUT + 2 * SZ_WOUT;
constexpr size_t SZ_WGU = (size_t)NGU * DM * 2;
constexpr size_t SZ_WGU8 = (size_t)NGU * DM, SZ_WD8 = (size_t)DM * DFF;
constexpr float WSC_UP = 32.f, WSC_DN = 64.f, HSC = 4.f;
constexpr size_t WS_FP2 = WS_WGU + 32 * MiB;
constexpr size_t WS_WD = WS_WGU + 9 * SZ_WGU;
constexpr size_t SZ_WD = (size_t)DM * DFF * 2;
constexpr size_t WS_X = WS_WD + 9 * SZ_WD;
constexpr size_t SZ_X = (size_t)MROWS * DM * 4;
constexpr size_t WS_XN = WS_X + SZ_X;
constexpr size_t SZ_XN = (size_t)MROWS * DM * 2;
constexpr size_t WS_R = WS_XN + SZ_XN;
constexpr size_t WS_PROJ = WS_R;
constexpr size_t SZ_PROJ = (size_t)MROWS * DIN * 2;
constexpr size_t WS_CAT = WS_PROJ + SZ_PROJ;
constexpr size_t WS_HID = WS_R;
constexpr size_t SZ_HID = (size_t)MAXSLOT * DFF * 2;
constexpr size_t WS_FP = WS_HID + SZ_HID;
constexpr size_t SZ_FP = (size_t)2 * NTOK * DM * 2;
constexpr size_t WS_END = WS_FP + SZ_FP;
constexpr size_t WS_PART = WS_R + 232 * MiB;
static_assert(WS_PART >= WS_R + (size_t)MROWS * DFF * 2 && WS_PART >= WS_CAT + SZ_XN && WS_PART + (size_t)14 * 512 * DM * 4 <= WS_FP, "PART placement");
static_assert(WS_CAT + SZ_XN <= WS_FP, "overlay");
static_assert(WS_WIN % 256 == 0 && WS_X % 256 == 0 && WS_R % 256 == 0, "align");
constexpr int CW_BAR = 4096;
constexpr int CW_COLMAX = 32768;
constexpr int CW_COLMAX_IN = 49152;
constexpr size_t WS_COLSC_IN = 1 * MiB + 640 * 1024;
constexpr size_t WS_COLSC = 3 * MiB + 832 * 1024;
constexpr size_t WS_ROWSC = 3 * MiB + 896 * 1024;

#define RLX_AGENT __ATOMIC_RELAXED, __HIP_MEMORY_SCOPE_AGENT
__device__ __forceinline__ unsigned f2bf(float f) { unsigned u = __builtin_bit_cast(unsigned, f); return (u + 0x7fffu + ((u >> 16) & 1u)) >> 16; }
__device__ __forceinline__ unsigned pk2(float lo, float hi) { return f2bf(lo) | (f2bf(hi) << 16); }
__device__ __forceinline__ float bf2f(unsigned short h) { return __builtin_bit_cast(float, (unsigned)h << 16); }
__device__ __forceinline__ float bflo(unsigned w) { return __builtin_bit_cast(float, w << 16); }
__device__ __forceinline__ float bfhi(unsigned w) { return __builtin_bit_cast(float, w & 0xffff0000u); }
typedef _Float16 f16x2_t __attribute__((ext_vector_type(2)));
__device__ __forceinline__ unsigned pkh2(float lo, float hi) { const f16x2_t h = {(_Float16)lo, (_Float16)hi}; return __builtin_bit_cast(unsigned, h); }
__device__ __forceinline__ f32x4 unpk_h4(unsigned w0, unsigned w1) { const f16x2_t a = __builtin_bit_cast(f16x2_t, w0), b = __builtin_bit_cast(f16x2_t, w1); return (f32x4){(float)a[0], (float)a[1], (float)b[0], (float)b[1]}; }
__device__ __forceinline__ unsigned cvt_pk_bf16(float lo, float hi) { unsigned r; asm volatile("v_cvt_pk_bf16_f32 %0, %1, %2" : "=v"(r) : "v"(lo), "v"(hi)); return r; }
__device__ __forceinline__ float xadd16(float v) { const auto r = __builtin_amdgcn_permlane16_swap(__float_as_uint(v), __float_as_uint(v), false, false); return __uint_as_float(r[0]) + __uint_as_float(r[1]); }
__device__ __forceinline__ float xadd32(float v) { const auto r = __builtin_amdgcn_permlane32_swap(__float_as_uint(v), __float_as_uint(v), false, false); return __uint_as_float(r[0]) + __uint_as_float(r[1]); }
__device__ __forceinline__ float fmax2(float a, float b) { return __builtin_amdgcn_fmed3f(a, b, __builtin_inff()); }
__device__ __forceinline__ float xmax16(float v) { const auto r = __builtin_amdgcn_permlane16_swap(__float_as_uint(v), __float_as_uint(v), false, false); return fmax2(__uint_as_float(r[0]), __uint_as_float(r[1])); }
__device__ __forceinline__ float xmax32(float v) { const auto r = __builtin_amdgcn_permlane32_swap(__float_as_uint(v), __float_as_uint(v), false, false); return fmax2(__uint_as_float(r[0]), __uint_as_float(r[1])); }
__device__ __forceinline__ float wave_sum(float v) {
#pragma unroll
    for (int o = 1; o < 16; o <<= 1) v += __shfl_xor(v, o);
    return xadd32(xadd16(v));
}
__device__ __forceinline__ float fast_silu(float x) { return x * __builtin_amdgcn_rcpf(1.0f + __builtin_amdgcn_exp2f(-x * LOG2E)); }
__device__ __forceinline__ int opaque_tid() { int t = threadIdx.x; asm volatile("" : "+v"(t)); return t; }
__device__ __forceinline__ const float* in_row(const float* x, const float* ctx, int m) {
    const int b = m / RPB, r = m - b * RPB;
    return r < CTXL ? ctx + ((size_t)b * CTXL + r) * DM : x + ((size_t)b * SEQ + (r - CTXL)) * DM;
}
namespace pg8 {
constexpr int BM = 256, BK = 64, HALF = 128, HTB = HALF * BK * 2  , STAGE_BYTES = 8 * HTB, NXCD = 8, WGM = 8;
__host__ __device__ __forceinline__ int lds_byte(int r, int c) { const int st = (r >> 4) * 2 + (c >> 5), rr = r & 15, cc = c & 31, ob = rr * 64 + cc * 2; return st * 1024 + (ob ^ (((ob >> 9) & 1) << 5)); }
__host__ __device__ __forceinline__ void stage_rc(int b, int& R, int& C) { const int st = b / 1024, sb = b % 1024, swz = sb ^ (((sb >> 9) & 1) << 5); R = (st >> 1) * 16 + swz / 64; C = (st & 1) * 32 + (swz % 64) / 2; }
__host__ __device__ __forceinline__ int perm32(int rho) { const int n = rho >> 4, i = rho & 15; return 8 * (i >> 2) + 4 * n + (i & 3); }

typedef int v4i_t __attribute__((ext_vector_type(4))); typedef int v8i_t __attribute__((ext_vector_type(8)));
__device__ __forceinline__ v8i_t cat8(bf16x8 lo, bf16x8 hi) { return __builtin_shufflevector(__builtin_bit_cast(v4i_t, lo), __builtin_bit_cast(v4i_t, hi), 0, 1, 2, 3, 4, 5, 6, 7); }
struct Unit { int pm, pn, e, ko; };
struct Gemm { const bf16_t* A; const bf16_t* Bt; int K; size_t bstride; int nt; };

struct StaticOrder {
    int nM, nN, nwg, G, c, skipctx, wrap, pm0; int ts[8];
    __device__ void init(int nM_, int nN_, int G_, int c_, int skip_) { nM = nM_; nN = nN_; nwg = nM * nN; G = G_; c = c_; skipctx = skip_; wrap = 0; pm0 = 0;
#pragma unroll
        for (int e = 0; e < 8; ++e) ts[e] = 0x7fffffff; ts[0] = 0; }
    __device__ bool next(int i, Unit& u) const {
        const long L = (long)i * G + c; if (L >= nwg) return false;
        int wgid = (int)L; { const int q = nwg / NXCD, r = nwg % NXCD, xcd = wgid % NXCD, off = wgid / NXCD; wgid = (xcd < r ? xcd * (q + 1) : r * (q + 1) + (xcd - r) * q) + off; }
        const int nig = WGM * nN, gid = wgid / nig, fm = gid * WGM, gsz = (nM - fm) < WGM ? (nM - fm) : WGM;
        int pm = pm0 + fm + ((wgid % nig) % gsz); u.pn = (wgid % nig) / gsz;
        int e = 0;
#pragma unroll
        for (int k = 1; k < 8; ++k) e += (pm >= ts[k]) ? 1 : 0;
        u.e = e; u.ko = 0;
        if (skipctx) pm = pm + 1 + (pm >= 32 ? 1 : 0);
        if (wrap) pm = (pm % wrap) + 1;
        u.pm = pm; return true;
    }
};

struct TailSplitOrder {
    StaticOrder S; int kob;
    __device__ bool next(int i, Unit& u) const { if (!S.next(i, u)) return false; const int kh = u.pn >> 3; u.pn &= 7; u.ko = kh * kob; return true; }
};
template <int NS>
struct CtxSplitOrder {
    int G, c, kob;
    __device__ bool next(int i, Unit& u) const { const int L = i * G + c; if (L >= 16 * NS) return false; const int ks = L % NS, tile = L / NS; u.pn = tile & 7; u.pm = (tile >> 3) * 33; u.e = ks; u.ko = ks * kob; return true; }
};
#define PG8_SA(b, h) (((b) * 2 + (h)) * HTB)
#define PG8_SB(b, h) ((4 + (b) * 2 + (h)) * HTB)
#define PG8_STAGE(bufoff, gbase, voff) do { _Pragma("unroll") for (int _i = 0; _i < 2; ++_i) \
        __builtin_amdgcn_global_load_lds((const unsigned*)((const char*)(gbase) + (voff)[_i]), (LAS unsigned*)(lds + (bufoff) + ldsw + _i * 8192), 16, 0, 0); } while (0)
#define PG8_STAGEA(bufoff, gbase, voff) do { _Pragma("unroll") for (int _i = 0; _i < 2; ++_i) \
        __builtin_amdgcn_global_load_lds((const unsigned*)((const char*)(gbase) + (voff)[_i]), (LAS unsigned*)(lds + (bufoff) + ldsw + _i * 8192), 16, 0, BLK ? 2 : 0); } while (0)
#define PG8_LDA(dst, b, h) do { _Pragma("unroll") for (int m = 0; m < 4; ++m) _Pragma("unroll") for (int k = 0; k < 2; ++k) dst[m][k] = *(const LAS bf16x8*)(lds + PG8_SA(b, h) + aoff + m * 2048 + k * 1024); } while (0)
#define PG8_LDB(dst, b, h) do { _Pragma("unroll") for (int n = 0; n < 2; ++n) _Pragma("unroll") for (int k = 0; k < 2; ++k) dst[n][k] = *(const LAS bf16x8*)(lds + PG8_SB(b, h) + boff + n * 2048 + k * 1024); } while (0)
#define PG8_MMA(ai, bj, At, Bt) do { __builtin_amdgcn_s_setprio(1); _Pragma("unroll") for (int m = 0; m < 4; ++m) _Pragma("unroll") for (int n = 0; n < 2; ++n) _Pragma("unroll") for (int k = 0; k < 2; ++k) \
        acc[ai][bj][m][n] = __builtin_amdgcn_mfma_f32_16x16x32_bf16(Bt[n][k], At[m][k], acc[ai][bj][m][n], 0, 0, 0); __builtin_amdgcn_s_setprio(0); } while (0)
#define PG8_MMA8(ai, bj, At, Bt) do { __builtin_amdgcn_s_setprio(1); _Pragma("unroll") for (int m = 0; m < 4; ++m) _Pragma("unroll") for (int n = 0; n < 2; ++n) \
        asm volatile("v_mfma_scale_f32_16x16x128_f8f6f4 %0, %1, %2, %0, %3, %3 op_sel_hi:[0,0,0]" : "+v"(acc[ai][bj][m][n]) : "v"(cat8(Bt[n][0], Bt[n][1])), "v"(cat8(At[m][0], At[m][1])), "v"(one_scale)); __builtin_amdgcn_s_setprio(0); } while (0)
#define PG8_MMAI(ai, bj, At, Bt) do { __builtin_amdgcn_s_setprio(1); _Pragma("unroll") for (int m = 0; m < 4; ++m) _Pragma("unroll") for (int n = 0; n < 2; ++n) _Pragma("unroll") for (int k = 0; k < 2; ++k) \
        acc[ai][bj][m][n] = __builtin_bit_cast(f32x4, __builtin_amdgcn_mfma_i32_16x16x64_i8(__builtin_bit_cast(v4i_t, Bt[n][k]), __builtin_bit_cast(v4i_t, At[m][k]), __builtin_bit_cast(v4i_t, acc[ai][bj][m][n]), 0, 0, 0)); __builtin_amdgcn_s_setprio(0); } while (0)
#define PG8_MM(ai, bj, At, Bt) do { if constexpr (F8) PG8_MMA8(ai, bj, At, Bt); else if constexpr (Epi::I8) PG8_MMAI(ai, bj, At, Bt); else PG8_MMA(ai, bj, At, Bt); } while (0)
#define PG8_WAIT_V(n) asm volatile("s_waitcnt vmcnt(" #n ")" ::: "memory")
#define PG8_WAIT_L(n) asm volatile("s_waitcnt lgkmcnt(" #n ")" ::: "memory")
#define PG8_BAR __builtin_amdgcn_s_barrier()
#define PG8_SCHED __builtin_amdgcn_sched_barrier(0)

template <class Epi, class Sched, bool GATHER, bool ALIGN_EPI, bool F8 = false, bool BLK = false>
__device__ __forceinline__ void gemm_phase(LAS unsigned char* lds, const Gemm g, const Sched& S, const Epi& E, const int* __restrict__ rowtok) {
    const int tid = opaque_tid(), wid = __builtin_amdgcn_readfirstlane(tid >> 6), lane = tid & 63, wr = wid >> 2, wc = wid & 3, fr = lane & 15, fq = lane >> 4;
    const int K = g.K, nt = g.nt;
    unsigned voffB[2]; int RA[2], CA[2];
#pragma unroll
    for (int i = 0; i < 2; ++i) { int R, C; stage_rc(tid * 16 + i * 8192, R, C); const int Rb = Epi::PERM ? ((R & ~31) + perm32(R & 31)) : R;
        RA[i] = R; CA[i] = C; voffB[i] = (unsigned)(Rb * (BLK ? BK : K) + C) * 2u; }
    const size_t kstep = BLK ? (size_t)(BM * BK * 2) : (size_t)(BK * 2);
    const size_t hstep = BLK ? (size_t)(HALF * BK * 2) : (size_t)HALF * K * 2;
    const size_t tstep = (size_t)BM * K * 2;
    const unsigned ldsw = (unsigned)wid * 1024u;
    const int aoff = lds_byte(wr * 64 + fr, fq * 8), boff = lds_byte(wc * 32 + fr, fq * 8);
#define PG8_SETA(v, u) do { _Pragma("unroll") for (int _h = 0; _h < 2; ++_h) _Pragma("unroll") for (int _i = 0; _i < 2; ++_i) { \
        int _row = (u).pm * BM + _h * HALF + RA[_i]; if constexpr (GATHER) _row = rowtok[_row]; \
        v[_h][_i] = BLK ? (unsigned)((_row >> 8) * (BM * K) + (_row & 255) * BK + CA[_i]) * 2u : (unsigned)(_row * K + CA[_i]) * 2u; } } while (0)
    Unit cur, nxt, nn; int ui = 0;
    if (!S.next(0, cur)) return;
    bool has_next = S.next(1, nxt);
    unsigned vA[2][2], vN[2][2];
    PG8_SETA(vA, cur);
    if (has_next) PG8_SETA(vN, nxt); else { _Pragma("unroll") for (int h = 0; h < 2; ++h) _Pragma("unroll") for (int i = 0; i < 2; ++i) vN[h][i] = vA[h][i]; }
    f32x4 acc[2][2][4][2];
#pragma unroll
    for (int a = 0; a < 2; ++a)
#pragma unroll
        for (int b = 0; b < 2; ++b)
#pragma unroll
            for (int m = 0; m < 4; ++m)
#pragma unroll
                for (int n = 0; n < 2; ++n) acc[a][b][m][n] = (f32x4){0.f, 0.f, 0.f, 0.f};
    bf16x8 At[4][2], B0[2][2], B1[2][2];
    const int one_scale = 0x7f7f7f7f;
    const char* cA = (const char*)g.A + cur.ko;
    const char* cB = (const char*)g.Bt + (size_t)cur.e * g.bstride + (size_t)cur.pn * tstep + cur.ko;
    PG8_STAGE(PG8_SB(0, 0), cB, voffB); PG8_STAGE(PG8_SB(0, 1), cB + hstep, voffB); PG8_STAGEA(PG8_SA(0, 0), cA, vA[0]); PG8_STAGEA(PG8_SA(0, 1), cA, vA[1]);
    if (wr == 1) PG8_BAR;
    PG8_WAIT_V(2); PG8_BAR;
    PG8_STAGE(PG8_SB(1, 0), cB + kstep, voffB); PG8_STAGEA(PG8_SA(1, 0), cA + kstep, vA[0]); PG8_STAGE(PG8_SB(1, 1), cB + hstep + kstep, voffB);
    PG8_WAIT_V(6); PG8_BAR;
    for (;;) {
        const char* nB = has_next ? (const char*)g.Bt + (size_t)nxt.e * g.bstride + (size_t)nxt.pn * tstep + nxt.ko : cB;
        const char* nA = has_next ? (const char*)g.A + nxt.ko : cA;
        for (int t = 0; t < nt; t += 2) {
            const bool last = (t == nt - 2);
            const char* a1 = cA + (size_t)(t + 1) * kstep;
            const char* a2 = last ? nA : cA + (size_t)(t + 2) * kstep; const char* b2 = last ? nB : cB + (size_t)(t + 2) * kstep;
            const char* a3 = a2 + kstep; const char* b3 = b2 + kstep;
            unsigned v2[2][2];
#pragma unroll
            for (int h = 0; h < 2; ++h)
#pragma unroll
                for (int i = 0; i < 2; ++i) v2[h][i] = last ? vN[h][i] : vA[h][i];
            PG8_LDB(B0, 0, 0); PG8_LDB(B1, 0, 1); PG8_SCHED; PG8_LDA(At, 0, 0); PG8_STAGEA(PG8_SA(1, 1), a1, vA[1]);
            PG8_WAIT_V(8); PG8_WAIT_L(0); PG8_BAR; PG8_MM(0, 0, At, B0); PG8_MM(0, 1, At, B1); PG8_BAR; PG8_SCHED;
            PG8_LDA(At, 0, 1); PG8_STAGE(PG8_SB(0, 0), b2, voffB); PG8_STAGE(PG8_SB(0, 1), b2 + hstep, voffB); PG8_STAGEA(PG8_SA(0, 0), a2, v2[0]);
            PG8_WAIT_V(8); PG8_WAIT_L(0); PG8_BAR; PG8_MM(1, 0, At, B0); PG8_MM(1, 1, At, B1); PG8_BAR; PG8_SCHED;
            PG8_LDB(B0, 1, 0); PG8_LDB(B1, 1, 1); PG8_SCHED; PG8_LDA(At, 1, 0); PG8_STAGEA(PG8_SA(0, 1), a2, v2[1]);
            PG8_WAIT_V(8); PG8_WAIT_L(0); PG8_BAR; PG8_MM(0, 0, At, B0); PG8_MM(0, 1, At, B1); PG8_BAR; PG8_SCHED;
            PG8_LDA(At, 1, 1); PG8_STAGE(PG8_SB(1, 0), b3, voffB); PG8_STAGE(PG8_SB(1, 1), b3 + hstep, voffB); PG8_STAGEA(PG8_SA(1, 0), a3, v2[0]);
            PG8_WAIT_V(8); PG8_WAIT_L(0); PG8_BAR; PG8_MM(1, 0, At, B0); PG8_MM(1, 1, At, B1); PG8_BAR; PG8_SCHED;
        }
        if constexpr (ALIGN_EPI) { if (wr == 0) PG8_BAR; }
        if constexpr (F8) { asm volatile("s_nop 15\n\ts_nop 15" ::: "memory");
            _Pragma("unroll") for (int a_ = 0; a_ < 2; ++a_) _Pragma("unroll") for (int b_ = 0; b_ < 2; ++b_) _Pragma("unroll") for (int m_ = 0; m_ < 4; ++m_) _Pragma("unroll") for (int n_ = 0; n_ < 2; ++n_) asm volatile("" : "+v"(acc[a_][b_][m_][n_])); }
        E(acc, cur, wr, wc, fr, fq);
        if (!has_next) break;
#pragma unroll
        for (int a = 0; a < 2; ++a)
#pragma unroll
            for (int b = 0; b < 2; ++b)
#pragma unroll
                for (int m = 0; m < 4; ++m)
#pragma unroll
                    for (int n = 0; n < 2; ++n) acc[a][b][m][n] = (f32x4){0.f, 0.f, 0.f, 0.f};
        cur = nxt; cB = nB; cA = nA; ++ui;
#pragma unroll
        for (int h = 0; h < 2; ++h)
#pragma unroll
            for (int i = 0; i < 2; ++i) vA[h][i] = vN[h][i];
        has_next = S.next(ui + 1, nn);
        if (has_next) { nxt = nn; PG8_SETA(vN, nxt); }
        if constexpr (ALIGN_EPI) { if (wr == 1) PG8_BAR; }
    }
    PG8_WAIT_V(0);
    if constexpr (!ALIGN_EPI) { if (wr == 0) PG8_BAR; }
    PG8_BAR;
#undef PG8_SETA
}


struct EpiProj {
    static constexpr bool PERM = true, IDEMP = true, I8 = false;
    bf16_t* P; const f32x2* rope;
    __device__ __forceinline__ void operator()(const f32x4 (&acc)[2][2][4][2], const Unit& u, int wr, int wc, int fr, int fq) const {
        const int pn = u.pn; const bool ctxp = (u.pm % 33) == 0;
        const int row0 = u.pm * BM + wr * 64 + fr;
#pragma unroll
        for (int bj = 0; bj < 2; ++bj) {
            const int cN = pn * BM + bj * HALF + wc * 32 + 8 * fq;
            const bool isrope = (pn == 14) || (pn == 15) || (pn == 16 && bj == 0);
            const float sc = (pn < 2 || pn == 14 || pn == 15) ? QSCALE : 1.0f;
            if (!isrope) {
#pragma unroll
                for (int ai = 0; ai < 2; ++ai)
#pragma unroll
                    for (int m = 0; m < 4; ++m) { const f32x4 v0 = acc[ai][bj][m][0] * sc, v1 = acc[ai][bj][m][1] * sc;
                        u32x4 w; w.x = cvt_pk_bf16(v0[0], v0[1]); w.y = cvt_pk_bf16(v0[2], v0[3]); w.z = cvt_pk_bf16(v1[0], v1[1]); w.w = cvt_pk_bf16(v1[2], v1[3]);
                        *(u32x4*)(P + (size_t)(row0 + ai * HALF + m * 16) * DIN + cN) = w; }
            } else {
                const int hrel = (wc & 1) * 32 + 8 * fq, hb = cN - hrel, a = hrel >> 3;
#pragma unroll
                for (int ai = 0; ai < 2; ++ai)
#pragma unroll
                    for (int m = 0; m < 4; ++m) { const int row = row0 + ai * HALF + m * 16;
                        f32x4 x1 = acc[ai][bj][m][0], x2 = acc[ai][bj][m][1], o1, o2;
                        if (!ctxp) { const int t = (row % RPB) - CTXL; const int pos = (wc & 1) ? (t & 63) : (t >> 6);
                            const f32x4* cs = (const f32x4*)(rope + pos * 16 + 4 * fq); const f32x4 c01 = cs[0], c23 = cs[1];
                            o1[0] = x1[0] * c01[0] - x2[0] * c01[1]; o2[0] = x1[0] * c01[1] + x2[0] * c01[0];
                            o1[1] = x1[1] * c01[2] - x2[1] * c01[3]; o2[1] = x1[1] * c01[3] + x2[1] * c01[2];
                            o1[2] = x1[2] * c23[0] - x2[2] * c23[1]; o2[2] = x1[2] * c23[1] + x2[2] * c23[0];
                            o1[3] = x1[3] * c23[2] - x2[3] * c23[3]; o2[3] = x1[3] * c23[3] + x2[3] * c23[2];
                        } else { o1 = x1; o2 = x2; }
                        o1 = o1 * sc; o2 = o2 * sc;
                        u32x2 w1, w2; w1.x = cvt_pk_bf16(o1[0], o1[1]); w1.y = cvt_pk_bf16(o1[2], o1[3]); w2.x = cvt_pk_bf16(o2[0], o2[1]); w2.y = cvt_pk_bf16(o2[2], o2[3]);
                        bf16_t* rp = P + (size_t)row * DIN + hb + 4 * a;
                        *(u32x2*)(rp) = w1; *(u32x2*)(rp + 32) = w2; }
            }
        }
    }
};
struct EpiProjI8 {
    static constexpr bool PERM = true, IDEMP = true, I8 = true;
    bf16_t* P; const f32x2* rope; const float* rowsc; const float* colsc;
    __device__ __forceinline__ void operator()(const f32x4 (&acc)[2][2][4][2], const Unit& u, int wr, int wc, int fr, int fq) const {
        const int pn = u.pn; const bool ctxp = (u.pm % 33) == 0;
        const int row0 = u.pm * BM + wr * 64 + fr;
        float rsv[2][4];
#pragma unroll
        for (int ai = 0; ai < 2; ++ai)
#pragma unroll
            for (int m = 0; m < 4; ++m) rsv[ai][m] = rowsc[row0 + ai * HALF + m * 16];
        f32x4 csv[2][2];
#pragma unroll
        for (int bj = 0; bj < 2; ++bj) { const int cN = pn * BM + bj * HALF + wc * 32 + 8 * fq; csv[bj][0] = *(const f32x4*)(colsc + cN); csv[bj][1] = *(const f32x4*)(colsc + cN + 4); }
        asm volatile("" ::: "memory");
#pragma unroll
        for (int bj = 0; bj < 2; ++bj) {
            const int cN = pn * BM + bj * HALF + wc * 32 + 8 * fq;
            const f32x4 cs0 = csv[bj][0], cs1 = csv[bj][1];
            const bool isrope = (pn == 14) || (pn == 15) || (pn == 16 && bj == 0);
            const float sc = (pn < 2 || pn == 14 || pn == 15) ? QSCALE : 1.0f;
            if (!isrope) {
#pragma unroll
                for (int ai = 0; ai < 2; ++ai)
#pragma unroll
                    for (int m = 0; m < 4; ++m) { const float rs = rsv[ai][m] * sc; f32x4 v0, v1;
                        _Pragma("unroll") for (int k = 0; k < 4; ++k) { v0[k] = (float)__float_as_int(acc[ai][bj][m][0][k]) * (rs * cs0[k]); v1[k] = (float)__float_as_int(acc[ai][bj][m][1][k]) * (rs * cs1[k]); }
                        u32x4 w; w.x = cvt_pk_bf16(v0[0], v0[1]); w.y = cvt_pk_bf16(v0[2], v0[3]); w.z = cvt_pk_bf16(v1[0], v1[1]); w.w = cvt_pk_bf16(v1[2], v1[3]);
                        *(u32x4*)(P + (size_t)(row0 + ai * HALF + m * 16) * DIN + cN) = w; }
            } else {
                const int hrel = (wc & 1) * 32 + 8 * fq, hb = cN - hrel, a = hrel >> 3;
#pragma unroll
                for (int ai = 0; ai < 2; ++ai) {
                    f32x4 rc01[4], rc23[4];
                    if (!ctxp) {
#pragma unroll
                        for (int m = 0; m < 4; ++m) { const int row = row0 + ai * HALF + m * 16; const int t = (row % RPB) - CTXL; const int pos = (wc & 1) ? (t & 63) : (t >> 6);
                            const f32x4* cs = (const f32x4*)(rope + pos * 16 + 4 * fq); rc01[m] = cs[0]; rc23[m] = cs[1]; } }
                    asm volatile("" ::: "memory");
#pragma unroll
                    for (int m = 0; m < 4; ++m) { const int row = row0 + ai * HALF + m * 16;
                        const float rs = rsv[ai][m]; f32x4 x1, x2, o1, o2;
                        _Pragma("unroll") for (int k = 0; k < 4; ++k) { x1[k] = (float)__float_as_int(acc[ai][bj][m][0][k]) * (rs * cs0[k]); x2[k] = (float)__float_as_int(acc[ai][bj][m][1][k]) * (rs * cs1[k]); }
                        if (!ctxp) { const f32x4 c01 = rc01[m], c23 = rc23[m];
                            o1[0] = x1[0] * c01[0] - x2[0] * c01[1]; o2[0] = x1[0] * c01[1] + x2[0] * c01[0];
                            o1[1] = x1[1] * c01[2] - x2[1] * c01[3]; o2[1] = x1[1] * c01[3] + x2[1] * c01[2];
                            o1[2] = x1[2] * c23[0] - x2[2] * c23[1]; o2[2] = x1[2] * c23[1] + x2[2] * c23[0];
                            o1[3] = x1[3] * c23[2] - x2[3] * c23[3]; o2[3] = x1[3] * c23[3] + x2[3] * c23[2];
                        } else { o1 = x1; o2 = x2; }
                        o1 = o1 * sc; o2 = o2 * sc;
                        u32x2 w1, w2; w1.x = cvt_pk_bf16(o1[0], o1[1]); w1.y = cvt_pk_bf16(o1[2], o1[3]); w2.x = cvt_pk_bf16(o2[0], o2[1]); w2.y = cvt_pk_bf16(o2[2], o2[3]);
                        bf16_t* rp = P + (size_t)row * DIN + hb + 4 * a;
                        *(u32x2*)(rp) = w1; *(u32x2*)(rp + 32) = w2; }
                }
            }
        }
    }
};
struct EpiResid {
    static constexpr bool PERM = true, IDEMP = false, I8 = false;
    unsigned short* X; const float* xin; const float* cin; const float* gate; int from_inputs; unsigned short* Xw;
    __device__ __forceinline__ void operator()(const f32x4 (&acc)[2][2][4][2], const Unit& u, int wr, int wc, int fr, int fq) const {
        const int b = u.pm / 33; const bool ctxp = (u.pm % 33) == 0; const float* gp = gate + (ctxp ? 2 : b) * 12288;
        const int col0 = u.pn * BM + wc * 32 + 8 * fq;
        f32x4 gv[2][2];
#pragma unroll
        for (int bj = 0; bj < 2; ++bj)
#pragma unroll
            for (int n = 0; n < 2; ++n) gv[bj][n] = *(const f32x4*)(gp + col0 + bj * HALF + 4 * n);
#pragma unroll
        for (int ai = 0; ai < 2; ++ai)
#pragma unroll
            for (int mp = 0; mp < 2; ++mp) {
                f32x4 r0[2][2], r1[2][2]; unsigned short* dst[2];
#pragma unroll
                for (int mm = 0; mm < 2; ++mm) { const int row = u.pm * BM + ai * HALF + wr * 64 + (2 * mp + mm) * 16 + fr;
                    const float* srcf = in_row(xin, cin, row); const unsigned short* srch = X + (size_t)row * DM; dst[mm] = Xw + (size_t)row * DM;
#pragma unroll
                    for (int bj = 0; bj < 2; ++bj) { const int c = col0 + bj * HALF;
                        if (from_inputs) { r0[mm][bj] = *(const f32x4*)(srcf + c); r1[mm][bj] = *(const f32x4*)(srcf + c + 4); }
                        else { const u32x4 w = *(const u32x4*)(srch + c); r0[mm][bj] = unpk_h4(w.x, w.y); r1[mm][bj] = unpk_h4(w.z, w.w); } } }
                asm volatile("" ::: "memory");
#pragma unroll
                for (int mm = 0; mm < 2; ++mm)
#pragma unroll
                    for (int bj = 0; bj < 2; ++bj) { const int c = col0 + bj * HALF, m = 2 * mp + mm;
                        const f32x4 o0 = r0[mm][bj] + gv[bj][0] * acc[ai][bj][m][0], o1 = r1[mm][bj] + gv[bj][1] * acc[ai][bj][m][1];
                        u32x4 ow; ow.x = pkh2(o0[0], o0[1]); ow.y = pkh2(o0[2], o0[3]); ow.z = pkh2(o1[0], o1[1]); ow.w = pkh2(o1[2], o1[3]);
                        *(u32x4*)(dst[mm] + c) = ow; }
                asm volatile("" ::: "memory");
            }
    }
};
struct EpiPart {
    static constexpr bool PERM = true, IDEMP = true, I8 = false;
    unsigned short* PART;
    __device__ __forceinline__ void operator()(const f32x4 (&acc)[2][2][4][2], const Unit& u, int wr, int wc, int fr, int fq) const {
        const int col0 = u.pn * BM + wc * 32 + 8 * fq; unsigned short* base = PART + ((size_t)u.e * 512 + (u.pm ? 256 : 0)) * DM;
#pragma unroll
        for (int ai = 0; ai < 2; ++ai)
#pragma unroll
            for (int m = 0; m < 4; ++m) { unsigned short* dst = base + (size_t)(ai * HALF + wr * 64 + m * 16 + fr) * DM + col0;
#pragma unroll
                for (int bj = 0; bj < 2; ++bj) { const f32x4 a0 = acc[ai][bj][m][0], a1 = acc[ai][bj][m][1];
                    u32x4 w; w.x = pkh2(a0[0], a0[1]); w.y = pkh2(a0[2], a0[3]); w.z = pkh2(a1[0], a1[1]); w.w = pkh2(a1[2], a1[3]);
                    *(u32x4*)(dst + bj * HALF) = w; } }
    }
};
struct EpiSwiglu {
    static constexpr bool PERM = true, IDEMP = true, I8 = false;
    bf16_t* H;
    __device__ __forceinline__ void operator()(const f32x4 (&acc)[2][2][4][2], const Unit& u, int wr, int wc, int fr, int fq) const {
        const int row0 = wr * 64 + fr; bf16_t* Hb = H + (size_t)u.pm * (BM * DFF) + (size_t)(2 * u.pn + (wc >> 1)) * (BM * BK) + (wc & 1) * 32 + 8 * fq;
#pragma unroll
        for (int ai = 0; ai < 2; ++ai)
#pragma unroll
            for (int m = 0; m < 4; ++m) { f32x4 h0, h1;
#pragma unroll
                for (int k = 0; k < 4; ++k) { h0[k] = fast_silu(acc[ai][0][m][0][k]) * acc[ai][1][m][0][k]; h1[k] = fast_silu(acc[ai][0][m][1][k]) * acc[ai][1][m][1][k]; }
                u32x4 w; w.x = cvt_pk_bf16(h0[0], h0[1]); w.y = cvt_pk_bf16(h0[2], h0[3]); w.z = cvt_pk_bf16(h1[0], h1[1]); w.w = cvt_pk_bf16(h1[2], h1[3]);
                *(u32x4*)(Hb + (row0 + ai * HALF + m * 16) * BK) = w; }
    }
};
struct EpiSwigluI8 {
    static constexpr bool PERM = true, IDEMP = true, I8 = true;
    bf16_t* H; const float* rowsc; const float* colsc;
    __device__ __forceinline__ void operator()(const f32x4 (&acc)[2][2][4][2], const Unit& u, int wr, int wc, int fr, int fq) const {
        const int row0 = wr * 64 + fr; bf16_t* Hb = H + (size_t)u.pm * (BM * DFF) + (size_t)(2 * u.pn + (wc >> 1)) * (BM * BK) + (wc & 1) * 32 + 8 * fq;
        const int cN = u.pn * BM + wc * 32 + 8 * fq;
        const f32x4 cg0 = *(const f32x4*)(colsc + cN), cg1 = *(const f32x4*)(colsc + cN + 4), cu0 = *(const f32x4*)(colsc + cN + HALF), cu1 = *(const f32x4*)(colsc + cN + HALF + 4);
        float rsv[2][4];
#pragma unroll
        for (int ai = 0; ai < 2; ++ai)
#pragma unroll
            for (int m = 0; m < 4; ++m) rsv[ai][m] = rowsc[u.pm * BM + row0 + ai * HALF + m * 16];
        asm volatile("" ::: "memory");
#pragma unroll
        for (int ai = 0; ai < 2; ++ai)
#pragma unroll
            for (int m = 0; m < 4; ++m) { const float rs = rsv[ai][m]; f32x4 h0, h1;
#pragma unroll
                for (int k = 0; k < 4; ++k) {
                    const float g0 = (float)__float_as_int(acc[ai][0][m][0][k]) * (rs * cg0[k]), u0 = (float)__float_as_int(acc[ai][1][m][0][k]) * (rs * cu0[k]);
                    const float g1 = (float)__float_as_int(acc[ai][0][m][1][k]) * (rs * cg1[k]), u1 = (float)__float_as_int(acc[ai][1][m][1][k]) * (rs * cu1[k]);
                    h0[k] = fast_silu(g0) * u0; h1[k] = fast_silu(g1) * u1;
                }
                u32x4 w; w.x = cvt_pk_bf16(h0[0], h0[1]); w.y = cvt_pk_bf16(h0[2], h0[3]); w.z = cvt_pk_bf16(h1[0], h1[1]); w.w = cvt_pk_bf16(h1[2], h1[3]);
                *(u32x4*)(Hb + (row0 + ai * HALF + m * 16) * BK) = w; }
    }
};
struct EpiMoeDown {
    static constexpr bool PERM = true, IDEMP = true, I8 = false;
    bf16_t* FP; const int* rowdst; const float* rowp; float sc; bf16_t* FP2;
    __device__ __forceinline__ void operator()(const f32x4 (&acc)[2][2][4][2], const Unit& u, int wr, int wc, int fr, int fq) const {
        const int col0 = u.pn * BM + wc * 32 + 8 * fq;
        int dstv[2][4]; float pv[2][4];
#pragma unroll
        for (int ai = 0; ai < 2; ++ai)
#pragma unroll
            for (int m = 0; m < 4; ++m) { const int slot = u.pm * BM + ai * HALF + wr * 64 + m * 16 + fr; const int d_ = rowdst[slot]; dstv[ai][m] = (u.ko != 0 && d_ >= 0) ? slot - 128 * BM : d_; pv[ai][m] = rowp[slot]; }
        asm volatile("" ::: "memory");
#pragma unroll
        for (int ai = 0; ai < 2; ++ai)
#pragma unroll
            for (int m = 0; m < 4; ++m) { const int dst = dstv[ai][m]; const float p = pv[ai][m] * sc;
                if (dst >= 0) { bf16_t* rp = (u.ko != 0 ? FP2 : FP) + (size_t)dst * DM + col0;
#pragma unroll
                    for (int bj = 0; bj < 2; ++bj) { const f32x4 v0 = acc[ai][bj][m][0] * p, v1 = acc[ai][bj][m][1] * p;
                        u32x4 w; w.x = cvt_pk_bf16(v0[0], v0[1]); w.y = cvt_pk_bf16(v0[2], v0[3]); w.z = cvt_pk_bf16(v1[0], v1[1]); w.w = cvt_pk_bf16(v1[2], v1[3]); *(u32x4*)(rp + bj * HALF) = w; } } }
    }
};
__device__ __forceinline__ unsigned pk_fp8x4(float a, float b, float c, float d) {
    a = __builtin_amdgcn_fmed3f(a, -448.f, 448.f); b = __builtin_amdgcn_fmed3f(b, -448.f, 448.f); c = __builtin_amdgcn_fmed3f(c, -448.f, 448.f); d = __builtin_amdgcn_fmed3f(d, -448.f, 448.f);
    int w = 0; w = __builtin_amdgcn_cvt_pk_fp8_f32(a, b, w, false); w = __builtin_amdgcn_cvt_pk_fp8_f32(c, d, w, true); return (unsigned)w; }
struct EpiSwiglu8 {
    static constexpr bool PERM = true, IDEMP = true, I8 = false;
    unsigned char* H; float ws_inv, hs;
    __device__ __forceinline__ void operator()(const f32x4 (&acc)[2][2][4][2], const Unit& u, int wr, int wc, int fr, int fq) const {
        const int row0 = u.pm * BM + wr * 64 + fr, col = u.pn * HALF + wc * 32 + 8 * fq;
        const float k1 = -ws_inv * LOG2E, ic = 1.0f / (ws_inv * ws_inv * hs);
#pragma unroll
        for (int ai = 0; ai < 2; ++ai)
#pragma unroll
            for (int m = 0; m < 4; ++m) { f32x4 h0, h1;
#pragma unroll
                for (int n = 0; n < 2; ++n) {
                    const f32x4 gq = acc[ai][0][m][n], uq = acc[ai][1][m][n];
                    const f32x4 tq = gq * k1, pq = gq * uq;
                    f32x4 eq; eq[0] = __builtin_amdgcn_exp2f(tq[0]); eq[1] = __builtin_amdgcn_exp2f(tq[1]); eq[2] = __builtin_amdgcn_exp2f(tq[2]); eq[3] = __builtin_amdgcn_exp2f(tq[3]);
                    const f32x4 dq = eq * ic + ic;
                    f32x4 rq; rq[0] = __builtin_amdgcn_rcpf(dq[0]); rq[1] = __builtin_amdgcn_rcpf(dq[1]); rq[2] = __builtin_amdgcn_rcpf(dq[2]); rq[3] = __builtin_amdgcn_rcpf(dq[3]);
                    const f32x4 hq = pq * rq;
                    if (n == 0) h0 = hq; else h1 = hq; }
                u32x2 w; w.x = pk_fp8x4(h0[0], h0[1], h0[2], h0[3]); w.y = pk_fp8x4(h1[0], h1[1], h1[2], h1[3]);
                *(u32x2*)(H + (size_t)(row0 + ai * HALF + m * 16) * DFF + col) = w; }
    }
};
}
namespace att {
constexpr int PITCH = 144, TILE = 64 * PITCH, BUF = 2 * TILE;
typedef short v4i16_t __attribute__((ext_vector_type(4)));
struct St { f32x4 o[4]; float m, l; };
__device__ __forceinline__ s16x4 vtr(const LAS char* p) { return __builtin_bit_cast(s16x4, __builtin_amdgcn_ds_read_tr16_b64_v4i16((LAS v4i16_t*)p)); }
__device__ __forceinline__ float fexp2(float x) { return __builtin_amdgcn_exp2f(x); }

template <int MODE>
__device__ __forceinline__ void chunk(const LAS char* kt, const LAS char* vt, const bf16x8 (&qf)[2], St& st, int lane, int pa, int pb, const LAS float* bias, const int (&bidx)[8], const bool (&bok)[8]) {
    const int mrow = lane & 15, g = lane >> 4;
    f32x4 s[2];
#pragma unroll
    for (int b = 0; b < 2; ++b) {
        const int krow = 8 * (mrow >> 2) + 4 * b + (mrow & 3);
        const LAS char* kp = kt + krow * PITCH + 16 * g;
        const bf16x8 a0 = *(const LAS bf16x8*)kp, a1 = *(const LAS bf16x8*)(kp + 64);
        f32x4 z = (f32x4){0.f, 0.f, 0.f, 0.f};
        z = __builtin_amdgcn_mfma_f32_16x16x32_bf16(a0, qf[0], z, 0, 0, 0);
        z = __builtin_amdgcn_mfma_f32_16x16x32_bf16(a1, qf[1], z, 0, 0, 0);
        s[b] = z;
    }
    float p[8]; float mx = -1e30f;
    const unsigned t0 = MODE == 2 ? (unsigned)(pa + 8 * g) : 0u, span = MODE == 2 ? (unsigned)pb : 0u;
#pragma unroll
    for (int b = 0; b < 2; ++b)
#pragma unroll
        for (int i = 0; i < 4; ++i) {
            float v = s[b][i];
            if (MODE == 1) { v += bias[bidx[4 * b + i]]; v = bok[4 * b + i] ? v : -1e30f; }
            if (MODE == 2) v = (t0 + (unsigned)(4 * b + i)) <= span ? v : -1e30f;
            p[4 * b + i] = v;
        }
    mx = fmax2(fmax2(fmax2(p[0], p[1]), fmax2(p[2], p[3])), fmax2(fmax2(p[4], p[5]), fmax2(p[6], p[7])));
    mx = xmax32(xmax16(mx));
    const float mn = fmax2(st.m, mx);
    const float alpha = fexp2(st.m - mn);
    float rs = 0.f;
#pragma unroll
    for (int k = 0; k < 8; ++k) { const float e = fexp2(p[k] - mn); p[k] = e; rs += e; }
    st.l = st.l * alpha + rs; st.m = mn;
#pragma unroll
    for (int d = 0; d < 4; ++d) st.o[d] = st.o[d] * alpha;
    u32x4 pw; pw.x = cvt_pk_bf16(p[0], p[1]); pw.y = cvt_pk_bf16(p[2], p[3]); pw.z = cvt_pk_bf16(p[4], p[5]); pw.w = cvt_pk_bf16(p[6], p[7]);
    const bf16x8 pbv = __builtin_bit_cast(bf16x8, pw);
    const LAS char* vp = vt + (8 * g + (mrow >> 2)) * PITCH + (mrow & 3) * 8;
#pragma unroll
    for (int d = 0; d < 4; ++d) {
        const s16x4 lo = vtr(vp + d * 32), hi = vtr(vp + d * 32 + 4 * PITCH);
        const bf16x8 af = (bf16x8){lo[0], lo[1], lo[2], lo[3], hi[0], hi[1], hi[2], hi[3]};
        st.o[d] = __builtin_amdgcn_mfma_f32_16x16x32_bf16(af, pbv, st.o[d], 0, 0, 0);
    }
}
template <int MODE>
__device__ __forceinline__ void chunk64(const LAS char* kt, const LAS char* vt, const bf16x8 (&qf)[2], St& st, int lane, int pa, int pb) {
    const int mrow = lane & 15, g = lane >> 4;
    f32x4 s[4];
#pragma unroll
    for (int b = 0; b < 4; ++b) {
        const int krow = 32 * (b >> 1) + 8 * (mrow >> 2) + 4 * (b & 1) + (mrow & 3);
        const LAS char* kp = kt + krow * PITCH + 16 * g;
        const bf16x8 a0 = *(const LAS bf16x8*)kp, a1 = *(const LAS bf16x8*)(kp + 64);
        f32x4 z = (f32x4){0.f, 0.f, 0.f, 0.f};
        z = __builtin_amdgcn_mfma_f32_16x16x32_bf16(a0, qf[0], z, 0, 0, 0);
        z = __builtin_amdgcn_mfma_f32_16x16x32_bf16(a1, qf[1], z, 0, 0, 0);
        s[b] = z;
    }
    float p[16];
    const unsigned t0 = MODE == 2 ? (unsigned)(pa + 8 * g) : 0u, span = MODE == 2 ? (unsigned)pb : 0u;
#pragma unroll
    for (int b = 0; b < 4; ++b)
#pragma unroll
        for (int i = 0; i < 4; ++i) {
            float v = s[b][i];
            if (MODE == 2) v = (t0 + (unsigned)(32 * (b >> 1) + 4 * (b & 1) + i)) <= span ? v : -1e30f;
            p[4 * b + i] = v;
        }
    float mx = fmax2(fmax2(fmax2(fmax2(p[0], p[1]), fmax2(p[2], p[3])), fmax2(fmax2(p[4], p[5]), fmax2(p[6], p[7]))),
                     fmax2(fmax2(fmax2(p[8], p[9]), fmax2(p[10], p[11])), fmax2(fmax2(p[12], p[13]), fmax2(p[14], p[15]))));
    mx = xmax32(xmax16(mx));
    const float mn = fmax2(st.m, mx);
    const float alpha = fexp2(st.m - mn);
    float rs0 = 0.f, rs1 = 0.f;
#pragma unroll
    for (int k = 0; k < 8; ++k) { const float e0 = fexp2(p[k] - mn), e1 = fexp2(p[8 + k] - mn); p[k] = e0; p[8 + k] = e1; rs0 += e0; rs1 += e1; }
    st.l = st.l * alpha + (rs0 + rs1); st.m = mn;
#pragma unroll
    for (int d = 0; d < 4; ++d) st.o[d] = st.o[d] * alpha;
#pragma unroll
    for (int hh = 0; hh < 2; ++hh) {
        u32x4 pw; pw.x = cvt_pk_bf16(p[8 * hh], p[8 * hh + 1]); pw.y = cvt_pk_bf16(p[8 * hh + 2], p[8 * hh + 3]); pw.z = cvt_pk_bf16(p[8 * hh + 4], p[8 * hh + 5]); pw.w = cvt_pk_bf16(p[8 * hh + 6], p[8 * hh + 7]);
        const bf16x8 pbv = __builtin_bit_cast(bf16x8, pw);
        const LAS char* vp = vt + (32 * hh + 8 * g + (mrow >> 2)) * PITCH + (mrow & 3) * 8;
#pragma unroll
        for (int d = 0; d < 4; ++d) {
            const s16x4 lo = vtr(vp + d * 32), hi = vtr(vp + d * 32 + 4 * PITCH);
            const bf16x8 af = (bf16x8){lo[0], lo[1], lo[2], lo[3], hi[0], hi[1], hi[2], hi[3]};
            st.o[d] = __builtin_amdgcn_mfma_f32_16x16x32_bf16(af, pbv, st.o[d], 0, 0, 0);
        }
    }
}
__device__ __forceinline__ void finish(St& st, bf16_t* dst  , int lane) {
    const int g = lane >> 4;
    const float lt = xadd32(xadd16(st.l));
    const float inv = 1.0f / lt;
#pragma unroll
    for (int d = 0; d < 4; ++d) { const f32x4 v = st.o[d] * inv; u32x2 w; w.x = cvt_pk_bf16(v[0], v[1]); w.y = cvt_pk_bf16(v[2], v[3]); *(u32x2*)(dst + 16 * d + 4 * g) = w; }
}

__device__ __forceinline__ void na_unit(const bf16_t* __restrict__ P, bf16_t* __restrict__ CAT, const float* __restrict__ rpb, LAS char* lds, int b, int hp, int r, int cq) {
    const int tid = opaque_tid(), lane = tid & 63, w = __builtin_amdgcn_readfirstlane(tid >> 6), half = w >> 2, jb = w & 3, ht = tid & 255, h = 2 * hp + half;
    LAS char* hb = lds + half * (2 * BUF);
    LAS float* rp = (LAS float*)(lds + 4 * BUF) + half * 512;
    const bool ctxq = r < 0;
    if (!ctxq) { const float r0 = rpb[h * 465 + ht], r1 = ht + 256 < 465 ? rpb[h * 465 + ht + 256] : 0.f; rp[ht] = r0 * LOG2E; if (ht + 256 < 465) rp[ht + 256] = r1 * LOG2E; }
    const int rowb = b * RPB, mrow = lane & 15, g = lane >> 4;
    const int m0 = ctxq ? rowb + cq * 64 + 16 * jb : rowb + CTXL + r * 64 + 16 * jb;
    bf16x8 qf[2]; { const bf16_t* qp = P + (size_t)(m0 + mrow) * DIN + C_QA + h * 64 + 8 * g; qf[0] = *(const bf16x8*)qp; qf[1] = *(const bf16x8*)(qp + 32); }
    int r0 = r - 4; r0 = r0 < 0 ? 0 : (r0 > GRH - 8 ? GRH - 8 : r0);
    const int NS = ctxq ? 4 : 12;
    int bidx[8]; bool bok[8];
    { const int qc = 16 * jb + mrow, wsc = jb == 0 ? 0 : (jb == 1 ? 8 : (jb == 2 ? 24 : 32)); int c0 = qc - 8; c0 = c0 < 0 ? 0 : (c0 > 48 ? 48 : c0);
#pragma unroll
      for (int k = 0; k < 8; ++k) { const int kc = wsc + 8 * g + k; bok[k] = (kc >= c0) && (kc < c0 + 16); int idx = kc - qc + 15; bidx[k] = idx < 0 ? 0 : (idx > 30 ? 30 : idx); } }
    u32x4 rgA[4], rgB[4];
#define NA_LOAD(rg, s) do { const int base_ = (s) < 4 ? rowb + 64 * (s) : rowb + CTXL + (r0 + (s) - 4) * 64; _Pragma("unroll") for (int i_ = 0; i_ < 4; ++i_) { const int idx_ = (ht + 256 * i_) & 511; \
        rg[i_] = *(const u32x4*)(P + (size_t)(base_ + (idx_ >> 3)) * DIN + (i_ < 2 ? C_KA : C_VA) + h * 64 + (idx_ & 7) * 8); } } while (0)
#define NA_STORE(rg, bf) do { _Pragma("unroll") for (int i_ = 0; i_ < 4; ++i_) { const int idx_ = (ht + 256 * i_) & 511; \
        *(LAS u32x4*)(hb + (bf) * BUF + (i_ < 2 ? 0 : TILE) + (idx_ >> 3) * PITCH + (idx_ & 7) * 16) = rg[i_]; } } while (0)
#define NA_STEP(s, bf) do { const LAS char* kt = hb + (bf) * BUF; const LAS char* vt = kt + TILE; \
        if ((s) < 4) { chunk64<0>(kt, vt, qf, st, lane, 0, 0); } \
        else { const int kr = r0 + (s) - 4, ws = jb == 0 ? 0 : (jb == 1 ? 8 : (jb == 2 ? 24 : 32)), dr = kr - r + 7; \
            chunk<1>(kt + ws * PITCH, vt + ws * PITCH, qf, st, lane, 0, 0, rp + dr * 31, bidx, bok); } } while (0)
    St st; st.m = -1e30f; st.l = 0.f;
#pragma unroll
    for (int d = 0; d < 4; ++d) st.o[d] = (f32x4){0.f, 0.f, 0.f, 0.f};
    NA_LOAD(rgA, 0); NA_LOAD(rgB, 1); NA_STORE(rgA, 0); NA_STORE(rgB, 1); __syncthreads();
    asm volatile("" : "+v"(qf[0]), "+v"(qf[1]));
    for (int s = 0; s < NS; s += 2) {
        const bool more = s + 2 < NS;
        if (more) { NA_LOAD(rgA, s + 2); NA_LOAD(rgB, s + 3); }
        NA_STEP(s, 0); NA_STEP(s + 1, 1);
        __syncthreads();
        if (more) { NA_STORE(rgA, 0); NA_STORE(rgB, 1); __syncthreads(); }
    }
#undef NA_STEP
#undef NA_LOAD
#undef NA_STORE
    finish(st, CAT + (size_t)(m0 + mrow) * DM + h * 64, lane);
}

__device__ __forceinline__ void swa_unit(const bf16_t* __restrict__ P, bf16_t* __restrict__ CAT, const float* __restrict__ sink, LAS char* lds, int b, int kh, int qblk, int cq) {
    const int tid = opaque_tid(), lane = tid & 63, w = __builtin_amdgcn_readfirstlane(tid >> 6), gq = w >> 1, sb = w & 1, head = kh * 4 + gq;
    const bool ctxq = qblk < 0;
    const int rowb = b * RPB, mrow = lane & 15, g = lane >> 4;
    const int m0 = ctxq ? rowb + cq * 32 + 16 * sb : rowb + CTXL + qblk * 32 + 16 * sb;
    const int qw = qblk * 32 + 16 * sb, qpos = qw + mrow;
    bf16x8 qf[2]; { const bf16_t* qp = P + (size_t)(m0 + mrow) * DIN + C_QD + head * 64 + 8 * g; qf[0] = *(const bf16x8*)qp; qf[1] = *(const bf16x8*)(qp + 32); }
    const int NS = ctxq ? 4 : 9;
    const int bidx[8] = {0, 0, 0, 0, 0, 0, 0, 0}; const bool bok[8] = {true, true, true, true, true, true, true, true};
    int klo = qpos - 128; klo = klo < 0 ? 0 : klo; int khi = qpos + 128; khi = khi > SEQ - 1 ? SEQ - 1 : khi; const int kspan = khi - klo;
    u32x4 rgA[2], rgB[2];
    const int skey = tid >> 3, sch = tid & 7;
#define SW_LOAD(rg, s) do { int row_; if ((s) < 4) row_ = rowb + 64 * (s) + skey; else { int kp_ = qblk * 32 - 128 + 64 * ((s) - 4) + skey; kp_ = kp_ < 0 ? 0 : (kp_ > SEQ - 1 ? SEQ - 1 : kp_); row_ = rowb + CTXL + kp_; } \
        const bf16_t* src_ = P + (size_t)row_ * DIN + kh * 64 + sch * 8; rg[0] = *(const u32x4*)(src_ + C_KD); rg[1] = *(const u32x4*)(src_ + C_VD); } while (0)
#define SW_STORE(rg, bf) do { LAS char* d_ = lds + (bf) * BUF + skey * PITCH + sch * 16; *(LAS u32x4*)d_ = rg[0]; *(LAS u32x4*)(d_ + TILE) = rg[1]; } while (0)
#define SW_STEP(s, bf) do { const LAS char* kt = lds + (bf) * BUF; const LAS char* vt = kt + TILE; \
        if ((s) < 4) { chunk64<0>(kt, vt, qf, st, lane, 0, 0); } \
        else { const int kpa = qblk * 32 - 128 + 64 * ((s) - 4), kpb = kpa + 32; \
            const bool skipa = (kpa > qw + 15 + 128) || (kpa + 31 < qw - 128) || (kpa + 31 < 0) || (kpa >= SEQ), skipb = (kpb > qw + 15 + 128) || (kpb + 31 < qw - 128) || (kpb + 31 < 0) || (kpb >= SEQ); \
            if (!skipa && !skipb) chunk64<2>(kt, vt, qf, st, lane, kpa - klo, kspan); \
            else { if (!skipa) chunk<2>(kt, vt, qf, st, lane, kpa - klo, kspan, nullptr, bidx, bok); \
                   if (!skipb) chunk<2>(kt + 32 * PITCH, vt + 32 * PITCH, qf, st, lane, kpb - klo, kspan, nullptr, bidx, bok); } } } while (0)
    St st; st.m = sink[head] * LOG2E; st.l = (g == 0) ? 1.f : 0.f;
#pragma unroll
    for (int d = 0; d < 4; ++d) st.o[d] = (f32x4){0.f, 0.f, 0.f, 0.f};
    SW_LOAD(rgA, 0); SW_LOAD(rgB, 1); SW_STORE(rgA, 0); SW_STORE(rgB, 1); __syncthreads();
    asm volatile("" : "+v"(qf[0]), "+v"(qf[1]));
    for (int s = 0; s < NS; s += 2) {
        const bool more = s + 2 < NS, more2 = s + 3 < NS;
        if (more) SW_LOAD(rgA, s + 2);
        if (more2) SW_LOAD(rgB, s + 3);
        SW_STEP(s, 0);
        if (s + 1 < NS) SW_STEP(s + 1, 1);
        __syncthreads();
        if (more) { SW_STORE(rgA, 0); if (more2) SW_STORE(rgB, 1); __syncthreads(); }
    }
#undef SW_STEP
#undef SW_LOAD
#undef SW_STORE
    finish(st, CAT + (size_t)(m0 + mrow) * DM + 1536 + head * 64, lane);
}

__device__ __forceinline__ void unpack8(const u32x4 w, float (&f)[8]) { f[0] = bflo(w.x); f[1] = bfhi(w.x); f[2] = bflo(w.y); f[3] = bfhi(w.y); f[4] = bflo(w.z); f[5] = bfhi(w.z); f[6] = bflo(w.w); f[7] = bfhi(w.w); }
template <int GI>
__device__ __forceinline__ void pc_wave(const bf16_t* __restrict__ P, bf16_t* __restrict__ CAT, const float* __restrict__ convw, int m0, int chunk) {
    constexpr int HW = 1 << GI;
    const int ch0 = GI * 128 + chunk * 8;
    const int b = m0 / RPB, r = m0 - b * RPB; const bool isctx = r < CTXL;
    const int t0 = isctx ? r : r - CTXL, n = isctx ? CTXL : SEQ;
    const bf16_t* row0 = P + (size_t)m0 * DIN;
    float w0[8], w1[8], w2[8];
#pragma unroll
    for (int k = 0; k < 8; ++k) { w0[k] = convw[ch0 + k]; w1[k] = convw[512 + ch0 + k]; w2[k] = convw[1024 + ch0 + k]; }
    float up[8], uc[8], S[8], a[8], c[8];
#pragma unroll
    for (int q = 0; q < 8; ++q) { up[q] = 0.f; S[q] = 0.f; }
    if (t0 > 0) { unpack8(*(const u32x4*)(row0 - DIN + C_GC + ch0), a); unpack8(*(const u32x4*)(row0 - DIN + C_XV + ch0), c);
#pragma unroll
        for (int q = 0; q < 8; ++q) up[q] = a[q] * c[q]; }
    { unpack8(*(const u32x4*)(row0 + C_GC + ch0), a); unpack8(*(const u32x4*)(row0 + C_XV + ch0), c);
#pragma unroll
      for (int q = 0; q < 8; ++q) uc[q] = a[q] * c[q]; }
#pragma unroll
    for (int d = -HW; d < HW; ++d) { const int j = t0 + d; if (j >= 0 && j < n) { unpack8(*(const u32x4*)(row0 + (ptrdiff_t)d * DIN + C_UB + ch0), a);
#pragma unroll
        for (int q = 0; q < 8; ++q) S[q] += a[q]; } }
    for (int k = 0; k < 8; ++k) {
        const int t = t0 + k; const bf16_t* row = row0 + (size_t)k * DIN;
        const bool hn = t + 1 < n, hp = t + HW < n, hm = t - HW >= 0;
        float un[8], gbv[8], ubt[8], ua[8], us[8];
        const u32x4 z = (u32x4){0u, 0u, 0u, 0u};
        const u32x4 l0 = hn ? *(const u32x4*)(row + DIN + C_GC + ch0) : z, l1 = hn ? *(const u32x4*)(row + DIN + C_XV + ch0) : z, l2 = *(const u32x4*)(row + C_GB + ch0),
                    l3 = *(const u32x4*)(row + C_UB + ch0), l4 = hp ? *(const u32x4*)(row + (ptrdiff_t)HW * DIN + C_UB + ch0) : z, l5 = hm ? *(const u32x4*)(row - (ptrdiff_t)HW * DIN + C_UB + ch0) : z;
        unpack8(l0, a); unpack8(l1, c);
#pragma unroll
        for (int q = 0; q < 8; ++q) un[q] = a[q] * c[q];
        unpack8(l2, gbv); unpack8(l3, ubt); unpack8(l4, ua); unpack8(l5, us);
        float y[8];
#pragma unroll
        for (int q = 0; q < 8; ++q) y[q] = gbv[q] * (w0[q] * up[q] + w1[q] * uc[q] + w2[q] * un[q]);
        u32x4 oc; oc.x = pk2(y[0], y[1]); oc.y = pk2(y[2], y[3]); oc.z = pk2(y[4], y[5]); oc.w = pk2(y[6], y[7]);
        const int m = m0 + k;
        *(u32x4*)(CAT + (size_t)m * DM + 1024 + ch0) = oc;
        int lo = t - HW; lo = lo < 0 ? 0 : lo; int hi = t + HW; hi = hi > n ? n : hi;
        const float ic = 1.0f / (float)(hi - lo);
        u32x4 ob; ob.x = pk2(S[0] * ic - ubt[0], S[1] * ic - ubt[1]); ob.y = pk2(S[2] * ic - ubt[2], S[3] * ic - ubt[3]); ob.z = pk2(S[4] * ic - ubt[4], S[5] * ic - ubt[5]); ob.w = pk2(S[6] * ic - ubt[6], S[7] * ic - ubt[7]);
        *(u32x4*)(CAT + (size_t)m * DM + 512 + ch0) = ob;
#pragma unroll
        for (int q = 0; q < 8; ++q) { S[q] += ua[q] - us[q]; up[q] = uc[q]; uc[q] = un[q]; }
    }
}
__device__ __forceinline__ void pc_unit(const bf16_t* __restrict__ P, bf16_t* __restrict__ CAT, const float* __restrict__ convw, int unit) {
    const int tid = opaque_tid(), lane = tid & 63, w = __builtin_amdgcn_readfirstlane(tid >> 6), gi = w & 3;
    const int m0 = unit * 64 + (w >> 2) * 32 + (lane >> 4) * 8, chunk = lane & 15;
    if (gi == 0) pc_wave<0>(P, CAT, convw, m0, chunk); else if (gi == 1) pc_wave<1>(P, CAT, convw, m0, chunk); else if (gi == 2) pc_wave<2>(P, CAT, convw, m0, chunk); else pc_wave<3>(P, CAT, convw, m0, chunk);
}
}
#define XB_TMO      128
#define XB_XCNT(j)  (256  + 64 * (j))
#define XB_XSUB(j)  (1280 + 64 * (j))
#define XB_XGEN(j)  (2304 + 64 * (j))
#define XB_TOP      3328
#define XB_TOPGEN   3392
#define XCD_BAR_WORDS 3456
#define XB_SPIN_CAP (1u << 18)

__device__ __forceinline__ unsigned xb_ld(unsigned* p)              { return __hip_atomic_load(p, __ATOMIC_RELAXED, __HIP_MEMORY_SCOPE_AGENT); }
__device__ __forceinline__ unsigned xb_add(unsigned* p, unsigned v) { return __hip_atomic_fetch_add(p, v, __ATOMIC_RELAXED, __HIP_MEMORY_SCOPE_AGENT); }
__device__ __forceinline__ unsigned xb_xcc_id() { return (unsigned)__builtin_amdgcn_s_getreg((3 << 11) | 20) & 0xFu; }
#define XB_SPIN(cond, bar) do { unsigned _sp = 0; while (cond) { __builtin_amdgcn_s_sleep(1); \
    if ((++_sp & 255u) == 0u) { if (xb_ld(&(bar)[XB_TMO])) break; if (_sp > XB_SPIN_CAP) { atomicAdd(&(bar)[XB_TMO], 1u); break; } } } } while (0)

struct XcdBarrier {
    unsigned* bar; unsigned x;
    volatile LAS unsigned* st;
};

__device__ __forceinline__ XcdBarrier xcd_barrier_post(unsigned* bar, volatile LAS unsigned* st) {
    XcdBarrier b; b.bar = bar; b.x = xb_xcc_id(); b.st = st;
    if (threadIdx.x == 0) (void)xb_add(&bar[XB_XCNT(b.x)], 1u);
    return b;
}
__device__ __forceinline__ void xcd_barrier_complete(unsigned* bar, unsigned x, unsigned& nloc, unsigned& nx) {
    const unsigned G = gridDim.x * gridDim.y * gridDim.z;
    unsigned sum, cnt, mine, sp = 0u;
    for (;;) {
        sum = 0u; cnt = 0u; mine = 0u;
#pragma unroll
        for (unsigned j = 0; j < 16; ++j) { const unsigned c = xb_ld(&bar[XB_XCNT(j)]); sum += c; cnt += (c > 0u) ? 1u : 0u; mine = (j == x) ? c : mine; }
        if (sum == G) break;
        __builtin_amdgcn_s_sleep(1);
        if ((++sp & 255u) == 0u) { if (xb_ld(&bar[XB_TMO])) break; if (sp > XB_SPIN_CAP) { atomicAdd(&bar[XB_TMO], 1u); break; } }
    }
    nloc = mine > 0u ? mine : 1u; nx = cnt > 0u ? cnt : 1u;
}

__device__ __forceinline__ void xcd_barrier(const XcdBarrier& b) {
    asm volatile("s_waitcnt vmcnt(0)" ::: "memory");
    __syncthreads();
    if (threadIdx.x == 0) {
        unsigned* bar = b.bar;
        __builtin_amdgcn_s_waitcnt(0);
        unsigned nloc = b.st[0], nx = b.st[1];
        if (nloc == 0u) { xcd_barrier_complete(bar, b.x, nloc, nx); b.st[0] = nloc; b.st[1] = nx; }
        const unsigned old = xb_add(&bar[XB_XSUB(b.x)], 1u);
        const unsigned gen = old / nloc;
        if (old + 1u == (gen + 1u) * nloc) {
            __builtin_amdgcn_fence(__ATOMIC_RELEASE, "agent");
            asm volatile("s_waitcnt vmcnt(0)" ::: "memory");
            const unsigned og = xb_add(&bar[XB_TOP], 1u);
            const unsigned tg = og / nx;
            if (og + 1u == (tg + 1u) * nx) xb_add(&bar[XB_TOPGEN], 1u);
            else XB_SPIN(xb_ld(&bar[XB_TOPGEN]) == tg, bar);
            __builtin_amdgcn_fence(__ATOMIC_ACQUIRE, "agent");
            xb_add(&bar[XB_XGEN(b.x)], 1u);
            asm volatile("s_waitcnt vmcnt(0)" ::: "memory");
        } else {
            XB_SPIN(xb_ld(&bar[XB_XGEN(b.x)]) == gen, bar);
            __builtin_amdgcn_fence(__ATOMIC_ACQUIRE, "agent");
            asm volatile("s_waitcnt vmcnt(0)" ::: "memory");
        }
    }
    __syncthreads();
}
constexpr int RING_BYTES = 131072;
constexpr int MISC_OFF = RING_BYTES + 320;
constexpr int LDS_BYTES = 147456;
constexpr int NWAVES = 8;

struct Args { const float* in[23]; float* out; unsigned char* ws; int ph_lo, ph_hi; };
enum { I_X = 0, I_C, I_CTX, I_CCTX, I_WADA, I_BADA, I_NMIX, I_NFFN, I_NFIN, I_WIN, I_WOUT, I_RPB, I_POOLW, I_POOLS, I_CONVW, I_SINK, I_FG, I_FU, I_FD, I_ROUTER, I_MG, I_MU, I_MD };

template <bool BLK = false>
__device__ __forceinline__ void tr_item(const float* __restrict__ W, int ldw, int scol, int k0, bf16_t* __restrict__ WT, int ldk, int n0, LAS float* scr, int lane) {
    const float* src = W + (size_t)(k0 + (lane >> 5)) * ldw + scol;
    float tv[32];
#pragma unroll
    for (int i = 0; i < 32; ++i) tv[i] = __builtin_nontemporal_load(src + (size_t)(2 * i) * ldw);
#pragma unroll
    for (int i = 0; i < 32; ++i) { const int kk = 2 * i + (lane >> 5); scr[kk * 33 + (lane & 31)] = tv[i]; }
    asm volatile("s_waitcnt lgkmcnt(0)" ::: "memory");
    const int c = lane & 7;
#pragma unroll
    for (int j = 0; j < 4; ++j) { const int n = (lane >> 3) + 8 * j; const LAS float* s = scr + (8 * c) * 33 + n;
        u32x4 o; o.x = pk2(s[0 * 33], s[1 * 33]); o.y = pk2(s[2 * 33], s[3 * 33]); o.z = pk2(s[4 * 33], s[5 * 33]); o.w = pk2(s[6 * 33], s[7 * 33]);
        if (BLK) { const int nn = n0 + n; *(u32x4*)(WT + (size_t)(nn >> 8) * (256 * (size_t)ldk) + (size_t)(k0 >> 6) * (256 * 64) + (nn & 255) * 64 + 8 * c) = o; }
        else *(u32x4*)(WT + (size_t)(n0 + n) * ldk + k0 + 8 * c) = o; }
    asm volatile("s_waitcnt lgkmcnt(0)" ::: "memory");
}

__device__ __forceinline__ void tr_item8(const float* __restrict__ W, int ldw, int scol, int k0, unsigned char* __restrict__ WT, int ldk, int n0, float sc, LAS float* scr, int lane) {
    const float* src = W + (size_t)(k0 + (lane >> 5)) * ldw + scol;
    float tv[32];
#pragma unroll
    for (int i = 0; i < 32; ++i) tv[i] = __builtin_nontemporal_load(src + (size_t)(2 * i) * ldw);
#pragma unroll
    for (int i = 0; i < 32; ++i) { const int kk = 2 * i + (lane >> 5); scr[kk * 33 + (lane & 31)] = tv[i]; }
    asm volatile("s_waitcnt lgkmcnt(0)" ::: "memory");
    const int n = lane >> 1, hf = lane & 1; const LAS float* s = scr + (32 * hf) * 33 + n;
    u32x4 o0, o1;
    o0.x = pg8::pk_fp8x4(s[0 * 33] * sc, s[1 * 33] * sc, s[2 * 33] * sc, s[3 * 33] * sc); o0.y = pg8::pk_fp8x4(s[4 * 33] * sc, s[5 * 33] * sc, s[6 * 33] * sc, s[7 * 33] * sc);
    o0.z = pg8::pk_fp8x4(s[8 * 33] * sc, s[9 * 33] * sc, s[10 * 33] * sc, s[11 * 33] * sc); o0.w = pg8::pk_fp8x4(s[12 * 33] * sc, s[13 * 33] * sc, s[14 * 33] * sc, s[15 * 33] * sc);
    o1.x = pg8::pk_fp8x4(s[16 * 33] * sc, s[17 * 33] * sc, s[18 * 33] * sc, s[19 * 33] * sc); o1.y = pg8::pk_fp8x4(s[20 * 33] * sc, s[21 * 33] * sc, s[22 * 33] * sc, s[23 * 33] * sc);
    o1.z = pg8::pk_fp8x4(s[24 * 33] * sc, s[25 * 33] * sc, s[26 * 33] * sc, s[27 * 33] * sc); o1.w = pg8::pk_fp8x4(s[28 * 33] * sc, s[29 * 33] * sc, s[30 * 33] * sc, s[31 * 33] * sc);
    unsigned char* dst = WT + (size_t)(n0 + n) * ldk + k0 + 32 * hf;
    *(u32x4*)dst = o0; *(u32x4*)(dst + 16) = o1;
    asm volatile("s_waitcnt lgkmcnt(0)" ::: "memory");
}

__device__ __forceinline__ unsigned pk_i8x4(float a, float b, float c, float d) {
    const int ia = (int)__builtin_rintf(a), ib = (int)__builtin_rintf(b), ic = (int)__builtin_rintf(c), id = (int)__builtin_rintf(d);
    return (unsigned)(ia & 255) | ((unsigned)(ib & 255) << 8) | ((unsigned)(ic & 255) << 16) | ((unsigned)(id & 255) << 24); }
__device__ __forceinline__ void tr_item_i8(const float* __restrict__ W, int ldw, int scol, int k0, unsigned char* __restrict__ WT, int ldk, int n0, const unsigned* __restrict__ colmax, LAS float* scr, int lane) {
    const float* src = W + (size_t)(k0 + (lane >> 5)) * ldw + scol;
    float tv[32];
#pragma unroll
    for (int i = 0; i < 32; ++i) tv[i] = __builtin_nontemporal_load(src + (size_t)(2 * i) * ldw);
#pragma unroll
    for (int i = 0; i < 32; ++i) { const int kk = 2 * i + (lane >> 5); scr[kk * 33 + (lane & 31)] = tv[i]; }
    asm volatile("s_waitcnt lgkmcnt(0)" ::: "memory");
    const int n = lane >> 1, hf = lane & 1; const LAS float* s = scr + (32 * hf) * 33 + n;
    const float cm = __uint_as_float(colmax[n0 + n]); const float sc = cm > 0.f ? 127.0f / cm : 0.f;
    u32x4 o0, o1;
    o0.x = pk_i8x4(s[0 * 33] * sc, s[1 * 33] * sc, s[2 * 33] * sc, s[3 * 33] * sc); o0.y = pk_i8x4(s[4 * 33] * sc, s[5 * 33] * sc, s[6 * 33] * sc, s[7 * 33] * sc);
    o0.z = pk_i8x4(s[8 * 33] * sc, s[9 * 33] * sc, s[10 * 33] * sc, s[11 * 33] * sc); o0.w = pk_i8x4(s[12 * 33] * sc, s[13 * 33] * sc, s[14 * 33] * sc, s[15 * 33] * sc);
    o1.x = pk_i8x4(s[16 * 33] * sc, s[17 * 33] * sc, s[18 * 33] * sc, s[19 * 33] * sc); o1.y = pk_i8x4(s[20 * 33] * sc, s[21 * 33] * sc, s[22 * 33] * sc, s[23 * 33] * sc);
    o1.z = pk_i8x4(s[24 * 33] * sc, s[25 * 33] * sc, s[26 * 33] * sc, s[27 * 33] * sc); o1.w = pk_i8x4(s[28 * 33] * sc, s[29 * 33] * sc, s[30 * 33] * sc, s[31 * 33] * sc);
    unsigned char* dst = WT + (size_t)(n0 + n) * ldk + k0 + 32 * hf;
    *(u32x4*)dst = o0; *(u32x4*)(dst + 16) = o1;
    asm volatile("s_waitcnt lgkmcnt(0)" ::: "memory");
}
__device__ __forceinline__ void quant_dense_up(const Args& a, LAS unsigned char* lds, int G) {
    const int tid = opaque_tid(), lane = tid & 63, wave = __builtin_amdgcn_readfirstlane(tid >> 6), j = lane & 31;
    unsigned char* ws = a.ws; const unsigned* colmax = (const unsigned*)(ws + WS_CTL) + CW_COLMAX;
    LAS float* scr = (LAS float*)(lds + wave * 8448);
    const int gw = blockIdx.x * NWAVES + wave, NGW = G * NWAVES;
    for (int r = gw; r < 32 * 448; r += NGW) { const int kb = r / 448, nb = r % 448, n0 = nb * 32, tile = n0 >> 8, o = n0 & 255; const bool isup = o >= 128;
        tr_item_i8(isup ? a.in[I_FU] : a.in[I_FG], DFF, tile * 128 + (o & 127) + j, kb * 64, ws + WS_WGU, DM, n0, colmax, scr, lane); }
    float* colsc = (float*)(ws + WS_COLSC);
    for (int i = blockIdx.x * 512 + tid; i < NGU; i += G * 512) colsc[i] = __uint_as_float(colmax[i]) * (1.0f / 127.0f);
}

__device__ __forceinline__ void quant_w_in(const Args& a, LAS unsigned char* lds, int G, int l) {
    const int tid = opaque_tid(), lane = tid & 63, wave = __builtin_amdgcn_readfirstlane(tid >> 6), j = lane & 31;
    unsigned char* ws = a.ws; const unsigned* colmax = (const unsigned*)(ws + WS_CTL) + CW_COLMAX_IN + l * DIN;
    LAS float* scr = (LAS float*)(lds + wave * 8448);
    const int gw = blockIdx.x * NWAVES + wave, NGW = G * NWAVES;
    for (int r = gw; r < 32 * 136; r += NGW) { const int kb = r / 136, nb = r % 136, n0 = nb * 32; int col = n0 + j;
        if (n0 >= C_QD && n0 < C_VD) { const int hbn = col & ~63, o = col & 63, aa = o >> 3, i = o & 7; col = hbn + (i < 4 ? 4 * aa + i : 32 + 4 * aa + (i - 4)); }
        tr_item_i8(a.in[I_WIN] + (size_t)l * DM * DIN, DIN, col, kb * 64, ws + WS_WIN + (size_t)l * SZ_WIN, DM, n0, colmax, scr, lane); }
    float* colsc = (float*)(ws + WS_COLSC_IN) + l * DIN;
    for (int i = blockIdx.x * 512 + tid; i < DIN; i += G * 512) colsc[i] = __uint_as_float(colmax[i]) * (1.0f / 127.0f);
}

__constant__ double ROPE_C1[16] = {0.54030230586813977, 0.84600911028170789, 0.95041528025518285, 0.98423023447009461, 0.99500416527802582, 0.99841927779266448, 0.99950004166527784, 0.99984189028361437, 0.99995000041666526, 0.9999841886533658, 0.99999500000416663, 0.99999841886158658, 0.99999950000004167, 0.99999984188612112, 0.99999995000000041, 0.99999998418861169};
__constant__ double ROPE_S1[16] = {0.8414709848078965, 0.53316843991402285, 0.31098359290718575, 0.17689218624615005, 0.099833416646828155, 0.056204499214692491, 0.031617506402433708, 0.01778185687966613, 0.0099998333341666645, 0.0056233836139601857, 0.0031622723897082477, 0.0017782784728035289, 0.00099999983333334168, 0.00056234129555235944, 0.00031622776074637522, 0.00017782794006665674};

__device__ __forceinline__ void p0_prologue(const Args& a, LAS unsigned char* lds, int G) {
    const int tid = opaque_tid(), lane = tid & 63, wave = __builtin_amdgcn_readfirstlane(tid >> 6);
    unsigned char* ws = a.ws;
    {
        LAS float* sv = (LAS float*)lds; LAS float* red = (LAS float*)(lds + 24576);
        { float xs[12];
#pragma unroll
          for (int q = 0; q < 12; ++q) { const int v = q >> 2, k = (tid + 512 * q) & 2047; xs[q] = v < 2 ? a.in[I_C][v * DM + k] : a.in[I_CCTX][k]; }
#pragma unroll
          for (int q = 0; q < 12; ++q) sv[tid + 512 * q] = xs[q] / (1.0f + expf(-xs[q])); }
        __syncthreads();
        float* MOD = (float*)(ws + WS_MOD);
        for (int unit = blockIdx.x; unit < 512; unit += G) {
            const int l = unit >> 8, n0 = (unit & 255) * 48;
            if (tid < 384) {
                const int cg = tid % 12, ks = tid / 12;
                const float* wp = a.in[I_WADA] + ((size_t)l * DM + 64 * ks) * 12288 + n0 + 4 * cg;
                f32x4 acc[3]; acc[0] = acc[1] = acc[2] = (f32x4){0.f, 0.f, 0.f, 0.f};
#pragma unroll 32
                for (int kk = 0; kk < 64; ++kk) { const f32x4 w = *(const f32x4*)(wp + (size_t)kk * 12288); const int k = 64 * ks + kk;
                    acc[0] += w * sv[k]; acc[1] += w * sv[DM + k]; acc[2] += w * sv[2 * DM + k]; }
#pragma unroll
                for (int v = 0; v < 3; ++v) *(LAS f32x4*)(red + (ks * 12 + cg) * 12 + v * 4) = acc[v];
            }
            __syncthreads();
            if (tid < 144) { const int v = tid / 48, c = tid % 48, cg = c >> 2, ci = c & 3; float s = 0.f;
                for (int ks = 0; ks < 32; ++ks) s += red[(ks * 12 + cg) * 12 + v * 4 + ci];
                MOD[(size_t)(l * 3 + v) * 12288 + n0 + c] = s + a.in[I_BADA][l * 12288 + n0 + c]; }
            __syncthreads();
        }
    }
    { const int gt = blockIdx.x * 512 + tid;
      if (gt < 128 * 16) { const int pos = gt >> 4, f = gt & 15; double cr = 1.0, ci = 0.0, br = ROPE_C1[f], bi = ROPE_S1[f];
#pragma unroll
          for (int bit = 0; bit < 7; ++bit) { if ((pos >> bit) & 1) { const double t = cr * br - ci * bi; ci = cr * bi + ci * br; cr = t; } const double t2 = br * br - bi * bi; bi = 2.0 * br * bi; br = t2; }
          ((f32x2*)(ws + WS_ROPE))[gt] = (f32x2){(float)cr, (float)ci}; } }
    { LAS float* woL = (LAS float*)lds; LAS float* pwL = (LAS float*)(lds + 32768);
      for (int it = blockIdx.x; it < 256; it += G) {
        const int l = it >> 7, g = (it >> 5) & 3, nb = it & 31;
        const float* pw = a.in[I_POOLW] + (size_t)((l * 4 + g) * 128) * 128;
        const float* sc = a.in[I_POOLS] + l * 512 + g * 128;
        const float* wo = a.in[I_WOUT] + ((size_t)l * DM + 512 + g * 128) * DM + nb * 64;
        f32x4 wv[4], pv[8]; float sv[4];
#pragma unroll
        for (int i = 0; i < 4; ++i) { const int idx = tid + 512 * i; wv[i] = *(const f32x4*)(wo + (size_t)(idx >> 4) * DM + 4 * (idx & 15)); sv[i] = sc[idx >> 4]; }
#pragma unroll
        for (int i = 0; i < 8; ++i) pv[i] = *(const f32x4*)(pw + 4 * (tid + 512 * i));
#pragma unroll
        for (int i = 0; i < 4; ++i) *(LAS f32x4*)(woL + 4 * (tid + 512 * i)) = wv[i] * sv[i];
#pragma unroll
        for (int i = 0; i < 8; ++i) *(LAS f32x4*)(pwL + 4 * (tid + 512 * i)) = pv[i];
        __syncthreads();
        float acc[16];
#pragma unroll
        for (int c = 0; c < 16; ++c) acc[c] = 0.f;
        for (int d = 0; d < 128; d += 4) {
            const float w0 = woL[d * 64 + lane], w1 = woL[(d + 1) * 64 + lane], w2 = woL[(d + 2) * 64 + lane], w3 = woL[(d + 3) * 64 + lane];
#pragma unroll
            for (int c = 0; c < 16; ++c) { const f32x4 p = *(const LAS f32x4*)(pwL + (16 * wave + c) * 128 + d); acc[c] += (p[0] * w0 + p[1] * w1) + (p[2] * w2 + p[3] * w3); }
        }
        bf16_t* dst = (bf16_t*)(ws + WS_WOUT + (size_t)l * SZ_WOUT) + (size_t)(nb * 64 + lane) * DM + 512 + g * 128 + 16 * wave;
        u32x4 o0, o1; o0.x = pk2(acc[0], acc[1]); o0.y = pk2(acc[2], acc[3]); o0.z = pk2(acc[4], acc[5]); o0.w = pk2(acc[6], acc[7]);
        o1.x = pk2(acc[8], acc[9]); o1.y = pk2(acc[10], acc[11]); o1.z = pk2(acc[12], acc[13]); o1.w = pk2(acc[14], acc[15]);
        *(u32x4*)dst = o0; *(u32x4*)(dst + 8) = o1;
        __syncthreads();
      } }
    {
        LAS float* scr = (LAS float*)(lds + wave * 8448);
        const int gw = blockIdx.x * NWAVES + wave, NGW = G * NWAVES, j = lane & 31;
        constexpr int T0 = 2 * 32 * 136, T1 = 2 * 24 * 64, T2 = 32 * 448, T3 = 112 * 64;
        for (int it = gw; it < T0 + T1 + T2 + T3; it += NGW) {
            int r = it;
            if (r < T0) { const int l = r / 4352; r -= l * 4352; const int kb = r / 136, nb = r % 136, n0 = nb * 32; int col = n0 + j;
                if (n0 >= C_QD && n0 < C_VD) { const int hbn = col & ~63, o = col & 63, aa = o >> 3, i = o & 7; col = hbn + (i < 4 ? 4 * aa + i : 32 + 4 * aa + (i - 4)); }
                { const float* src = a.in[I_WIN] + (size_t)l * DM * DIN + (size_t)(kb * 64 + (lane >> 5)) * DIN + col; float mxv = 0.f;
#pragma unroll
                  for (int i = 0; i < 32; ++i) mxv = fmaxf(mxv, fabsf(__builtin_nontemporal_load(src + (size_t)(2 * i) * DIN)));
                  mxv = fmaxf(mxv, __shfl_xor(mxv, 32));
                  if (lane < 32) atomicMax((unsigned*)(ws + WS_CTL) + CW_COLMAX_IN + l * DIN + n0 + j, __float_as_uint(mxv)); }
                continue; }
            r -= T0;
            if (r < T1) { const int l = r / 1536; r -= l * 1536; int kb = r / 64; const int nb = r % 64; kb = kb < 8 ? kb : kb + 8;
                tr_item(a.in[I_WOUT] + (size_t)l * DM * DM, DM, nb * 32 + j, kb * 64, (bf16_t*)(ws + WS_WOUT + (size_t)l * SZ_WOUT), DM, nb * 32, scr, lane); continue; }
            r -= T1;
            if (r < T2) { const int kb = r / 448, nb = r % 448, n0 = nb * 32, tile = n0 >> 8, o = n0 & 255; const bool isup = o >= 128;
                const float* src = (isup ? a.in[I_FU] : a.in[I_FG]) + (size_t)(kb * 64 + (lane >> 5)) * DFF + tile * 128 + (o & 127) + j; float mxv = 0.f;
#pragma unroll
                for (int i = 0; i < 32; ++i) mxv = fmaxf(mxv, fabsf(__builtin_nontemporal_load(src + (size_t)(2 * i) * DFF)));
                mxv = fmaxf(mxv, __shfl_xor(mxv, 32));
                if (lane < 32) atomicMax((unsigned*)(ws + WS_CTL) + CW_COLMAX + n0 + j, __float_as_uint(mxv)); continue; }
            r -= T2;
            { const int kb = r / 64, nb = r % 64; tr_item<true>(a.in[I_FD], DM, nb * 32 + j, kb * 64, (bf16_t*)(ws + WS_WD), DFF, nb * 32, scr, lane); }
        }
    }
}

constexpr int CW_Q = 8192, CW_DONE = 8256;
constexpr int QI_UP = 8 * 32 * 448, QI_DN = 8 * 112 * 64, QGRABS = (QI_UP + QI_DN) / 8;
__device__ __forceinline__ void moe_conv_fill(const Args& a, LAS unsigned char* lds, int G, int done_word) {
    const int tid = opaque_tid(), lane = tid & 63, wave = __builtin_amdgcn_readfirstlane(tid >> 6), j = lane & 31;
    unsigned char* ws = a.ws; unsigned* ctl = (unsigned*)(ws + WS_CTL);
    LAS float* scr = (LAS float*)(lds + wave * 8448); volatile LAS int* shw = (volatile LAS int*)(lds + 8 * 8448);
    if (done_word >= 0 && tid == 0) __hip_atomic_fetch_add(ctl + done_word, 1u, RLX_AGENT);
    for (;;) {
        if (tid == 0) { int g = -1; const bool stop = done_word >= 0 && __hip_atomic_load(ctl + done_word, RLX_AGENT) >= (unsigned)G;
            if (!stop) { g = (int)__hip_atomic_fetch_add(ctl + CW_Q, 1u, RLX_AGENT); if (g >= QGRABS) g = -1; } shw[0] = g; }
        __syncthreads();
        const int g = shw[0];
        __syncthreads();
        if (g < 0) break;
        int r = g * 8 + wave;
        if (r < QI_UP) { const int e = r / 14336; r -= e * 14336; const int kb = r / 448, nb = r % 448, n0 = nb * 32, tile = n0 >> 8, o = n0 & 255; const bool isup = o >= 128;
            tr_item8((isup ? a.in[I_MU] : a.in[I_MG]) + (size_t)e * DM * DFF, DFF, tile * 128 + (o & 127) + j, kb * 64, ws + WS_WGU + SZ_WGU + (size_t)e * SZ_WGU8, DM, n0, WSC_UP, scr, lane); }
        else { r -= QI_UP; const int e = r / 7168; r -= e * 7168; const int kb = r / 64, nb = r % 64;
            tr_item8(a.in[I_MD] + (size_t)e * DFF * DM, DM, nb * 32 + j, kb * 64, ws + WS_WD + SZ_WD + (size_t)e * SZ_WD8, DFF, nb * 32, WSC_DN, scr, lane); }
    }
}

template <bool ROUTE, bool OUT_I8 = false>
__device__ __forceinline__ void norm_phase(const Args& a, LAS unsigned char* lds, int G, const float* gain, const float* mod, int shc, int scc, bool from_inputs, const float* router, const unsigned short* part, const float* pgate, int nparts, bool ctx_in) {
    const int tid = opaque_tid(), lane = tid & 63, wave = __builtin_amdgcn_readfirstlane(tid >> 6);
    unsigned char* ws = a.ws;
    LAS float* GT = (LAS float*)lds; LAS float* SH = GT + 3 * DM; LAS float* RT = SH + 3 * DM;
    LAS int* ES = (LAS int*)(RT + 8 * DM);
    for (int i = tid; i < 3 * DM; i += 512) { const int v = i >> 11, c = i & 2047; GT[i] = gain[c] * (1.0f + mod[v * 12288 + scc * DM + c]); SH[i] = mod[v * 12288 + shc * DM + c]; }
    if (ROUTE) for (int i = tid; i < 8 * DM; i += 512) { const int c = i >> 3, e = i & 7; RT[e * DM + c] = router[i]; }
    __syncthreads();
    const unsigned short* X = (const unsigned short*)(ws + WS_X); bf16_t* XN = (bf16_t*)(ws + WS_XN);
    const int ngroups = ROUTE ? NTOK / 64 : MROWS / 64;
    for (int grp = blockIdx.x; grp < ngroups; grp += G) {
        auto rowm = [&](int k) -> int { if (ROUTE) { const int tk = grp * 64 + wave * 8 + k; return (tk / SEQ) * RPB + CTXL + (tk % SEQ); } return grp * 64 + wave * 8 + k; };
        auto f32row = [&](int m) -> bool { const int b = m / RPB, r = m - b * RPB; return from_inputs || (!ROUTE && part != nullptr && r < CTXL && ctx_in); };
        auto proc = [&](f32x4 (&x)[8], const int m, const int k) {
            const int b = m / RPB, r = m - b * RPB, v = r < CTXL ? 2 : b;
            const bool cpart = !ROUTE && part != nullptr && r < CTXL;
            float ss = 0.f;
            if (cpart) {
#pragma unroll
                for (int j = 0; j < 8; ++j) { f32x4 sacc = (f32x4){0.f, 0.f, 0.f, 0.f}; const unsigned short* pp = part + (size_t)(b * 256 + r) * DM + 4 * lane + 256 * j;
                    for (int sI = 0; sI < nparts; ++sI) { const u32x2 pw_ = *(const u32x2*)(pp + (size_t)sI * 512 * DM); sacc += unpk_h4(pw_.x, pw_.y); }
                    x[j] += *(const f32x4*)(pgate + 4 * lane + 256 * j) * sacc;
                    if (ctx_in) { u32x2 wv; wv.x = pkh2(x[j][0], x[j][1]); wv.y = pkh2(x[j][2], x[j][3]); *(u32x2*)((unsigned short*)(ws + WS_X) + (size_t)m * DM + 4 * lane + 256 * j) = wv; } } }
#pragma unroll
            for (int j = 0; j < 8; ++j) ss += (x[j][0] * x[j][0] + x[j][1] * x[j][1]) + (x[j][2] * x[j][2] + x[j][3] * x[j][3]);
            const float rstd = 1.0f / sqrtf(wave_sum(ss) * (1.0f / DM) + EPS);
            float lg[8];
#pragma unroll
            for (int e = 0; e < 8; ++e) lg[e] = 0.f;
            float qs = 0.f;
            if (OUT_I8) {
                float am = 0.f;
#pragma unroll
                for (int j = 0; j < 8; ++j) { const int c = 4 * lane + 256 * j; const f32x4 gv = *(const LAS f32x4*)(GT + v * DM + c), sh = *(const LAS f32x4*)(SH + v * DM + c);
                    const f32x4 h = x[j] * rstd * gv + sh; am = fmaxf(am, fmaxf(fmaxf(fabsf(h[0]), fabsf(h[1])), fmaxf(fabsf(h[2]), fabsf(h[3])))); }
#pragma unroll
                for (int o = 1; o < 64; o <<= 1) am = fmaxf(am, __shfl_xor(am, o));
                qs = am > 0.f ? 127.0f / am : 0.f;
                if (lane == 0) ((float*)(ws + WS_ROWSC))[m] = am * (1.0f / 127.0f);
            }
#pragma unroll
            for (int j = 0; j < 8; ++j) { const int c = 4 * lane + 256 * j; const f32x4 gv = *(const LAS f32x4*)(GT + v * DM + c), sh = *(const LAS f32x4*)(SH + v * DM + c);
                const f32x4 h = x[j] * rstd * gv + sh;
                if (OUT_I8) { *(unsigned*)((unsigned char*)XN + (size_t)m * DM + c) = pk_i8x4(h[0] * qs, h[1] * qs, h[2] * qs, h[3] * qs); }
                else if (ROUTE) { *(unsigned*)((unsigned char*)XN + (size_t)m * DM + c) = pg8::pk_fp8x4(h[0], h[1], h[2], h[3]); }
                else { u32x2 w; w.x = pk2(h[0], h[1]); w.y = pk2(h[2], h[3]); *(u32x2*)(XN + (size_t)m * DM + c) = w; }
                if (ROUTE) {
#pragma unroll
                    for (int e = 0; e < 8; ++e) { const f32x4 rv = *(const LAS f32x4*)(RT + e * DM + c); lg[e] += (h[0] * rv[0] + h[1] * rv[1]) + (h[2] * rv[2] + h[3] * rv[3]); } } }
            if (ROUTE) {
#pragma unroll
                for (int e = 0; e < 8; ++e) lg[e] = wave_sum(lg[e]);
                int e0 = 0; float v0 = lg[0];
#pragma unroll
                for (int e = 1; e < 8; ++e) if (lg[e] > v0) { v0 = lg[e]; e0 = e; }
                int e1 = -1; float v1 = -3.0e38f;
#pragma unroll
                for (int e = 0; e < 8; ++e) if (e != e0 && lg[e] > v1) { v1 = lg[e]; e1 = e; }
                const float p1 = 1.0f / (1.0f + expf(v0 - v1)), p0 = 1.0f - p1;
                if (lane == 0) { const int tk = grp * 64 + wave * 8 + k; ES[(wave * 8 + k) * 2] = e0; ES[(wave * 8 + k) * 2 + 1] = e1;
                    ((f32x2*)(ws + WS_ROUTE + 262144))[tk] = (f32x2){p0, p1}; }
            }
                };
        if (from_inputs) {
            for (int k = 0; k < 8; ++k) { const int m = rowm(k); const float* src = in_row(a.in[I_X], a.in[I_CTX], m); f32x4 x[8];
#pragma unroll
                for (int j = 0; j < 8; ++j) x[j] = *(const f32x4*)(src + 4 * lane + 256 * j);
                proc(x, m, k); }
        } else {
            for (int k = 0; k < 8; k += 2) { const int m0 = rowm(k), m1 = rowm(k + 1); const bool q0 = f32row(m0), q1 = f32row(m1);
                f32x4 x0[8], x1[8]; u32x2 w0[8], w1[8];
                if (q0) { const float* src = in_row(a.in[I_X], a.in[I_CTX], m0);
#pragma unroll
                    for (int j = 0; j < 8; ++j) x0[j] = *(const f32x4*)(src + 4 * lane + 256 * j); }
                else { const unsigned short* src = X + (size_t)m0 * DM;
#pragma unroll
                    for (int j = 0; j < 8; ++j) w0[j] = *(const u32x2*)(src + 4 * lane + 256 * j); }
                if (q1) { const float* src = in_row(a.in[I_X], a.in[I_CTX], m1);
#pragma unroll
                    for (int j = 0; j < 8; ++j) x1[j] = *(const f32x4*)(src + 4 * lane + 256 * j); }
                else { const unsigned short* src = X + (size_t)m1 * DM;
#pragma unroll
                    for (int j = 0; j < 8; ++j) w1[j] = *(const u32x2*)(src + 4 * lane + 256 * j); }
                if (!q0) {
#pragma unroll
                    for (int j = 0; j < 8; ++j) x0[j] = unpk_h4(w0[j].x, w0[j].y); }
                proc(x0, m0, k);
                if (!q1) {
#pragma unroll
                    for (int j = 0; j < 8; ++j) x1[j] = unpk_h4(w1[j].x, w1[j].y); }
                proc(x1, m1, k + 1); }
        }
        if (ROUTE) {
            __syncthreads();
            if (wave == 0) { const int e0 = ES[lane * 2], e1 = ES[lane * 2 + 1]; int lr0 = 0, lr1 = 0; int mycnt = 0;
#pragma unroll
                for (int e = 0; e < 8; ++e) { const unsigned long long mk = __ballot(e0 == e || e1 == e); const int below = __popcll(mk & ((1ull << lane) - 1ull));
                    if (e0 == e) lr0 = below; if (e1 == e) lr1 = below; if (lane == e) mycnt = __popcll(mk); }
                ((int4*)(ws + WS_ROUTE))[grp * 64 + lane] = make_int4(e0, e1, lr0, lr1);
                if (lane < 8) ((int*)(ws + WS_CNT))[grp * 8 + lane] = mycnt; }
            __syncthreads();
        }
    }
}

__device__ __forceinline__ void slot_phase(const Args& a, LAS unsigned char* lds, int G) {
    const int tid = opaque_tid(), lane = tid & 63;
    unsigned char* ws = a.ws;
    LAS int* C = (LAS int*)lds; LAS int* TOT = C + 2048; LAS int* BASE = TOT + 8; LAS int* P = BASE + 8;
    const int* CNT = (const int*)(ws + WS_CNT);
    for (int i = tid; i < 2048; i += 512) C[i] = CNT[i];
    __syncthreads();
    { const int e = __builtin_amdgcn_readfirstlane(tid >> 6);
      const int v0 = C[(4 * lane) * 8 + e], v1 = C[(4 * lane + 1) * 8 + e], v2 = C[(4 * lane + 2) * 8 + e], v3 = C[(4 * lane + 3) * 8 + e];
      const int s = (v0 + v1) + (v2 + v3); int sc = s;
#pragma unroll
      for (int o = 1; o < 64; o <<= 1) { const int t = __shfl_up(sc, o); if (lane >= o) sc += t; }
      const int ex = sc - s;
      P[(4 * lane) * 8 + e] = ex; P[(4 * lane + 1) * 8 + e] = ex + v0; P[(4 * lane + 2) * 8 + e] = ex + v0 + v1; P[(4 * lane + 3) * 8 + e] = ex + v0 + v1 + v2;
      if (lane == 63) TOT[e] = sc; }
    __syncthreads();
    if (tid == 0) { int ts = 0; for (int e = 0; e < 8; ++e) { BASE[e] = ts * 256; if (blockIdx.x == 0) ((int*)(ws + WS_TILES))[1 + e] = ts; ts += (TOT[e] + 255) >> 8; } if (blockIdx.x == 0) ((int*)(ws + WS_TILES))[0] = ts; }
    __syncthreads();
    int* ROWTOK = (int*)(ws + WS_ROWTOK); int* ROWDST = (int*)(ws + WS_ROWDST); float* ROWP = (float*)(ws + WS_ROWP);
    for (int grp = blockIdx.x; grp < NTOK / 64; grp += G) {
        if (tid < 64) { const int tk = grp * 64 + lane; const int4 rt = ((const int4*)(ws + WS_ROUTE))[tk]; const f32x2 pp = ((const f32x2*)(ws + WS_ROUTE + 262144))[tk];
            const int m = (tk / SEQ) * RPB + CTXL + (tk % SEQ);
            const int s0 = BASE[rt.x] + P[grp * 8 + rt.x] + rt.z, s1 = BASE[rt.y] + P[grp * 8 + rt.y] + rt.w;
            ROWTOK[s0] = m; ROWDST[s0] = 2 * tk; ROWP[s0] = pp[0];
            ROWTOK[s1] = m; ROWDST[s1] = 2 * tk + 1; ROWP[s1] = pp[1];
            ((int*)(ws + WS_TAILF))[tk] = (s0 >= 128 * 256 || s1 >= 128 * 256) ? 1 : 0; ((int*)(ws + WS_SLOTS))[2 * tk] = s0; ((int*)(ws + WS_SLOTS))[2 * tk + 1] = s1; }
    }
    { const int e = blockIdx.x & 7; const int lo = BASE[e] + TOT[e], hi = BASE[e] + (((TOT[e] + 255) >> 8) << 8);
      for (int s = lo + (blockIdx.x >> 3) * 512 + tid; s < hi; s += ((G + 7) >> 3) * 512) { ROWTOK[s] = CTXL; ROWDST[s] = -1; ROWP[s] = 0.f; } }
}

__device__ __forceinline__ void final_phase(const Args& a, int nwg, int wgi, int tailmode) {
    const int tid = opaque_tid(), lane = tid & 63, wave = __builtin_amdgcn_readfirstlane(tid >> 6);
    unsigned char* ws = a.ws;
    const unsigned short* X = (const unsigned short*)(ws + WS_X); const bf16_t* FP = (const bf16_t*)(ws + WS_FP); const bf16_t* FP2 = (const bf16_t*)(ws + WS_FP2);
    const float* mod1 = (const float*)(ws + WS_MOD) + 3 * 12288;
    const float* gf = a.in[I_NFIN];
    const int* tailf = (const int*)(ws + WS_TAILF);
    const int tk0 = wgi * NWAVES + wave, tstep = nwg * NWAVES;
    for (int base = tk0; base < NTOK; base += 64 * tstep) {
      const int tkl = base + lane * tstep;
      unsigned long long todo = __ballot(tkl < NTOK && tailf[tkl] == tailmode);
      while (todo) {
        const int jb = __builtin_ctzll(todo); todo &= todo - 1;
        const int tk = base + jb * tstep;
        const int b = tk / SEQ, m = b * RPB + CTXL + (tk % SEQ);
        const float* g2 = mod1 + b * 12288 + 5 * DM;
        int sl0 = 0, sl1 = 0; if (tailmode) { sl0 = ((const int*)(ws + WS_SLOTS))[2 * tk]; sl1 = ((const int*)(ws + WS_SLOTS))[2 * tk + 1]; }
        f32x4 x[8]; float ss = 0.f;
#pragma unroll
        for (int j = 0; j < 8; ++j) { const int c = 4 * lane + 256 * j; const u32x2 xw = *(const u32x2*)(X + (size_t)m * DM + c); const f32x4 xv = unpk_h4(xw.x, xw.y), gv = *(const f32x4*)(g2 + c);
            const u32x2 f0 = *(const u32x2*)(FP + (size_t)(2 * tk) * DM + c), f1 = *(const u32x2*)(FP + (size_t)(2 * tk + 1) * DM + c);
            f32x4 f; f[0] = bflo(f0.x) + bflo(f1.x); f[1] = bfhi(f0.x) + bfhi(f1.x); f[2] = bflo(f0.y) + bflo(f1.y); f[3] = bfhi(f0.y) + bfhi(f1.y);
            if (tailmode) {
                if (sl0 >= 128 * 256) { const u32x2 g0 = *(const u32x2*)(FP2 + (size_t)(sl0 - 128 * 256) * DM + c); f[0] += bflo(g0.x); f[1] += bfhi(g0.x); f[2] += bflo(g0.y); f[3] += bfhi(g0.y); }
                if (sl1 >= 128 * 256) { const u32x2 g1 = *(const u32x2*)(FP2 + (size_t)(sl1 - 128 * 256) * DM + c); f[0] += bflo(g1.x); f[1] += bfhi(g1.x); f[2] += bflo(g1.y); f[3] += bfhi(g1.y); } }
            x[j] = xv + gv * f; ss += (x[j][0] * x[j][0] + x[j][1] * x[j][1]) + (x[j][2] * x[j][2] + x[j][3] * x[j][3]); }
        const float rstd = 1.0f / sqrtf(wave_sum(ss) * (1.0f / DM) + EPS);
#pragma unroll
        for (int j = 0; j < 8; ++j) { const int c = 4 * lane + 256 * j; const f32x4 gv = *(const f32x4*)(gf + c); *(f32x4*)(a.out + (size_t)tk * DM + c) = x[j] * rstd * gv; }
      }
    }
}
constexpr int N_PHASES = 18;
#ifndef MK_PER_PHASE
#define MK_PER_PHASE 0
#endif

__global__ void __launch_bounds__(NWAVES * 64, 2) mk_fwd(Args a) {
    extern __shared__ __attribute__((aligned(16))) unsigned char lds_raw[];
    LAS unsigned char* lds = (LAS unsigned char*)lds_raw;
    volatile LAS unsigned* MISC = (volatile LAS unsigned*)(lds + MISC_OFF);
    const int tid = threadIdx.x, G = gridDim.x;
    unsigned char* ws = a.ws;
    for (int u = tid; u < (LDS_BYTES - RING_BYTES) / 4; u += NWAVES * 64) ((LAS unsigned*)(lds + RING_BYTES))[u] = 0u;
    __syncthreads();
    const int lo = a.ph_lo, hi = a.ph_hi;
    XcdBarrier bar; bar.bar = (unsigned*)(ws + WS_CTL) + CW_BAR; bar.x = 0; bar.st = nullptr;
    if (hi - lo > 1) bar = xcd_barrier_post((unsigned*)(ws + WS_CTL) + CW_BAR, MISC + 8);
#define IN(k) (lo <= (k) && (k) < hi)
#define PHASE_REP(k) for (int rep_ = 0; rep_ < 1; ++rep_)
#define GRIDBAR() do { XcdBarrier b_ = bar; asm volatile("" : "+s"(b_.bar)); xcd_barrier(b_); } while (0)
#define SEAM(k) do { if ((k) + 1 < hi) { XcdBarrier b_ = bar; asm volatile("" : "+s"(b_.bar)); xcd_barrier(b_); } } while (0)
    float* MOD = (float*)(ws + WS_MOD);
    unsigned short* X = (unsigned short*)(ws + WS_X); bf16_t* XN = (bf16_t*)(ws + WS_XN); bf16_t* PROJ = (bf16_t*)(ws + WS_PROJ); bf16_t* CAT = (bf16_t*)(ws + WS_CAT);
    bf16_t* HID = (bf16_t*)(ws + WS_HID); bf16_t* FP = (bf16_t*)(ws + WS_FP);

    if (IN(0)) { PHASE_REP(0) { p0_prologue(a, lds, G); __syncthreads(); moe_conv_fill(a, lds, G, -1); } SEAM(0); }

    { constexpr int l = 0;
        const int pb = 1 + 8 * l;
        const float* modl = MOD + (size_t)l * 3 * 12288;
        if (IN(pb + 0)) { PHASE_REP(pb + 0) { norm_phase<false, true>(a, lds, G, a.in[I_NMIX] + l * DM, modl, 0, 1, l == 0, nullptr, l == 1 ? (const unsigned short*)(ws + WS_PART) : nullptr, MOD + 2 * 12288 + 5 * DM, 14, false); __syncthreads(); quant_w_in(a, lds, G, l); } SEAM(pb + 0); }
        if (IN(pb + 1)) { PHASE_REP(pb + 1) {
            pg8::Gemm g{XN, (const bf16_t*)(ws + WS_WIN + (size_t)l * SZ_WIN), DM / 2, 0, DM / 128};
            pg8::StaticOrder S; S.init(NPAN, DIN / 256, G, (int)blockIdx.x, 0);
            pg8::EpiProjI8 E{PROJ, (const f32x2*)(ws + WS_ROPE), (const float*)(ws + WS_ROWSC), (const float*)(ws + WS_COLSC_IN) + l * DIN};
            pg8::gemm_phase<pg8::EpiProjI8, pg8::StaticOrder, false, true>(lds, g, S, E, nullptr);
            } SEAM(pb + 1);
        }
        if (IN(pb + 2)) { PHASE_REP(pb + 2) {
            const float* sink = a.in[I_SINK] + l * 8; const float* rpb = a.in[I_RPB] + (size_t)l * 8 * 465; const float* convw = a.in[I_CONVW] + l * 3 * 512;
            { const bool sw = (G == 256); const int xcd = (int)blockIdx.x & 7, w = (int)blockIdx.x >> 3;
              for (int j = 0, i = blockIdx.x; i < 1024; ++j, i += G) { const int b_ = sw ? xcd >> 2 : i >> 9, kh_ = sw ? (xcd >> 1) & 1 : (i >> 8) & 1, q_ = sw ? (xcd & 1) * 128 + j * 32 + w : i & 255;
                  att::swa_unit(PROJ, CAT, sink, (LAS char*)lds, b_, kh_, q_, 0); }
              for (int j = 0, i = blockIdx.x; i < 1024; ++j, i += G) { const int b_ = sw ? xcd >> 2 : i >> 9, hp_ = sw ? xcd & 3 : (i >> 7) & 3, r_ = sw ? j * 32 + w : i & 127;
                  att::na_unit(PROJ, CAT, rpb, (LAS char*)lds, b_, hp_, r_, 0); } }
            if (l == 0) {
                for (int i = G - 1 - (int)blockIdx.x; i < 32; i += G) att::na_unit(PROJ, CAT, rpb, (LAS char*)lds, i >> 4, (i >> 2) & 3, -1, i & 3);
                for (int i = ((G - 33 - (int)blockIdx.x) % G + G) % G; i < 32; i += G) att::swa_unit(PROJ, CAT, sink, (LAS char*)lds, i >> 4, (i >> 3) & 1, -1, i & 7);
                for (int k = 0; k * G < MROWS / 64; ++k) { const int u = k * G + (((int)blockIdx.x - 64 * k) % G + G) % G; if (u < MROWS / 64) att::pc_unit(PROJ, CAT, convw, u); }
            } else {
                for (int i = blockIdx.x; i < NTOK / 64; i += G) att::pc_unit(PROJ, CAT, convw, (i >> 7) * 132 + 4 + (i & 127));
            }
            }
            SEAM(pb + 2);
        }
        if (IN(pb + 3)) { PHASE_REP(pb + 3) {
            pg8::Gemm g{CAT, (const bf16_t*)(ws + WS_WOUT + (size_t)l * SZ_WOUT), DM, 0, DM / 64};
            pg8::StaticOrder S; S.init(NPAN - 2, DM / 256, G, (int)blockIdx.x, 1);
            pg8::EpiResid E{X, a.in[I_X], a.in[I_CTX], modl + 2 * DM, l == 0 ? 1 : 0, rep_ ? (unsigned short*)(ws + WS_END) : X};
            pg8::gemm_phase<pg8::EpiResid, pg8::StaticOrder, false, true>(lds, g, S, E, nullptr);
            if (l == 0) {
                pg8::Gemm g2{CAT, (const bf16_t*)(ws + WS_WOUT), DM, 0, 8};
                pg8::CtxSplitOrder<4> S2{G, (int)blockIdx.x, 8 * 64 * 2};
                pg8::EpiPart E2{(unsigned short*)(ws + WS_PART)};
                pg8::gemm_phase<pg8::EpiPart, pg8::CtxSplitOrder<4>, false, true>(lds, g2, S2, E2, nullptr);
            }
            } SEAM(pb + 3);
        }
        if (l == 0) {
            if (IN(pb + 4)) { PHASE_REP(pb + 4) { norm_phase<false, true>(a, lds, G, a.in[I_NFFN], modl, 3, 4, false, nullptr, (const unsigned short*)(ws + WS_PART), MOD + 2 * 12288 + 2 * DM, 4, true); __syncthreads(); quant_dense_up(a, lds, G); } SEAM(pb + 4); }
            if (IN(pb + 6)) { PHASE_REP(pb + 6) {
                pg8::Gemm g{XN, (const bf16_t*)(ws + WS_WGU), DM / 2, 0, DM / 128};
                pg8::StaticOrder S; S.init(NPAN, NGU / 256, G, (int)blockIdx.x, 0);
                pg8::EpiSwigluI8 E{HID, (const float*)(ws + WS_ROWSC), (const float*)(ws + WS_COLSC)};
                pg8::gemm_phase<pg8::EpiSwigluI8, pg8::StaticOrder, false, true>(lds, g, S, E, nullptr);

                } SEAM(pb + 6);
            }
            if (IN(pb + 7)) { PHASE_REP(pb + 7) {
                pg8::Gemm g{HID, (const bf16_t*)(ws + WS_WD), DFF, 0, DFF / 64};
                pg8::StaticOrder S; S.init(NPAN - 2, DM / 256, G, (int)blockIdx.x, 1);
                pg8::EpiResid E{X, a.in[I_X], a.in[I_CTX], modl + 5 * DM, 0, rep_ ? (unsigned short*)(ws + WS_END) : X};
                pg8::gemm_phase<pg8::EpiResid, pg8::StaticOrder, false, true, false, true>(lds, g, S, E, nullptr);
                pg8::Gemm g2{HID, (const bf16_t*)(ws + WS_WD), DFF, 0, 8};
                pg8::CtxSplitOrder<14> S2{G, (int)blockIdx.x, 8 * 256 * 64 * 2};
                pg8::EpiPart E2{(unsigned short*)(ws + WS_PART)};
                pg8::gemm_phase<pg8::EpiPart, pg8::CtxSplitOrder<14>, false, true, false, true>(lds, g2, S2, E2, nullptr);
                } SEAM(pb + 7);
            }
        } else {
            if (IN(pb + 4)) { PHASE_REP(pb + 4) { norm_phase<true>(a, lds, G, a.in[I_NFFN] + DM, modl, 3, 4, false, a.in[I_ROUTER], nullptr, nullptr, 0, false); } SEAM(pb + 4); }
            if (IN(pb + 5)) { slot_phase(a, lds, G); SEAM(pb + 5); }
            if (IN(pb + 6)) { PHASE_REP(pb + 6) {
                const int* TL = (const int*)(ws + WS_TILES);
                pg8::Gemm g{XN, (const bf16_t*)(ws + WS_WGU + SZ_WGU), DM / 2, SZ_WGU8, DM / 128};
                pg8::StaticOrder S; S.init(TL[0], NGU / 256, G, (int)blockIdx.x, 0);
#pragma unroll
                for (int e = 0; e < 8; ++e) S.ts[e] = TL[1 + e];
                pg8::EpiSwiglu8 E{(unsigned char*)HID, 1.0f / WSC_UP, HSC};
                pg8::gemm_phase<pg8::EpiSwiglu8, pg8::StaticOrder, true, true, true>(lds, g, S, E, (const int*)(ws + WS_ROWTOK));
                } SEAM(pb + 6);
            }
            if (IN(pb + 7)) { PHASE_REP(pb + 7) {
                const int* TL = (const int*)(ws + WS_TILES);
                pg8::Gemm g{HID, (const bf16_t*)(ws + WS_WD + SZ_WD), DFF / 2, SZ_WD8, DFF / 128};
                const int nmain = TL[0] < 128 ? TL[0] : 128, ntail = (TL[0] - nmain) * (DM / 256) * 2;
                pg8::StaticOrder S; S.init(nmain, DM / 256, G, (int)blockIdx.x, 0);
#pragma unroll
                for (int e = 0; e < 8; ++e) S.ts[e] = TL[1 + e];
                pg8::EpiMoeDown E{FP, (const int*)(ws + WS_ROWDST), (const float*)(ws + WS_ROWP), 1.0f / (WSC_DN * HSC), (bf16_t*)(ws + WS_FP2)};
                pg8::gemm_phase<pg8::EpiMoeDown, pg8::StaticOrder, false, true, true>(lds, g, S, E, nullptr);
                GRIDBAR();
                if ((int)blockIdx.x < ntail) {
                    pg8::TailSplitOrder S2; S2.S.init(TL[0] - nmain, 2 * (DM / 256), ntail, (int)blockIdx.x, 0); S2.S.pm0 = nmain; S2.kob = DFF / 2;
#pragma unroll
                    for (int e = 0; e < 8; ++e) S2.S.ts[e] = TL[1 + e];
                    pg8::Gemm g2 = g; g2.nt = DFF / 128 / 2;
                    pg8::gemm_phase<pg8::EpiMoeDown, pg8::TailSplitOrder, false, true, true>(lds, g2, S2, E, nullptr);
                } else final_phase(a, G - ntail, (int)blockIdx.x - ntail, 0);
                } SEAM(pb + 7);
            }
        }
        }
    { constexpr int l = 1;
        const int pb = 1 + 8 * l;
        const float* modl = MOD + (size_t)l * 3 * 12288;
        if (IN(pb + 0)) { PHASE_REP(pb + 0) { norm_phase<false, true>(a, lds, G, a.in[I_NMIX] + l * DM, modl, 0, 1, l == 0, nullptr, l == 1 ? (const unsigned short*)(ws + WS_PART) : nullptr, MOD + 2 * 12288 + 5 * DM, 14, false); __syncthreads(); quant_w_in(a, lds, G, l); } SEAM(pb + 0); }
        if (IN(pb + 1)) { PHASE_REP(pb + 1) {
            pg8::Gemm g{XN, (const bf16_t*)(ws + WS_WIN + (size_t)l * SZ_WIN), DM / 2, 0, DM / 128};
            pg8::StaticOrder S; S.init(NPAN, DIN / 256, G, (int)blockIdx.x, 0);
            pg8::EpiProjI8 E{PROJ, (const f32x2*)(ws + WS_ROPE), (const float*)(ws + WS_ROWSC), (const float*)(ws + WS_COLSC_IN) + l * DIN};
            pg8::gemm_phase<pg8::EpiProjI8, pg8::StaticOrder, false, true>(lds, g, S, E, nullptr);
            } SEAM(pb + 1);
        }
        if (IN(pb + 2)) { PHASE_REP(pb + 2) {
            const float* sink = a.in[I_SINK] + l * 8; const float* rpb = a.in[I_RPB] + (size_t)l * 8 * 465; const float* convw = a.in[I_CONVW] + l * 3 * 512;
            { const bool sw = (G == 256); const int xcd = (int)blockIdx.x & 7, w = (int)blockIdx.x >> 3;
              for (int j = 0, i = blockIdx.x; i < 1024; ++j, i += G) { const int b_ = sw ? xcd >> 2 : i >> 9, kh_ = sw ? (xcd >> 1) & 1 : (i >> 8) & 1, q_ = sw ? (xcd & 1) * 128 + j * 32 + w : i & 255;
                  att::swa_unit(PROJ, CAT, sink, (LAS char*)lds, b_, kh_, q_, 0); }
              for (int j = 0, i = blockIdx.x; i < 1024; ++j, i += G) { const int b_ = sw ? xcd >> 2 : i >> 9, hp_ = sw ? xcd & 3 : (i >> 7) & 3, r_ = sw ? j * 32 + w : i & 127;
                  att::na_unit(PROJ, CAT, rpb, (LAS char*)lds, b_, hp_, r_, 0); } }
            if (l == 0) {
                for (int i = G - 1 - (int)blockIdx.x; i < 32; i += G) att::na_unit(PROJ, CAT, rpb, (LAS char*)lds, i >> 4, (i >> 2) & 3, -1, i & 3);
                for (int i = ((G - 33 - (int)blockIdx.x) % G + G) % G; i < 32; i += G) att::swa_unit(PROJ, CAT, sink, (LAS char*)lds, i >> 4, (i >> 3) & 1, -1, i & 7);
                for (int k = 0; k * G < MROWS / 64; ++k) { const int u = k * G + (((int)blockIdx.x - 64 * k) % G + G) % G; if (u < MROWS / 64) att::pc_unit(PROJ, CAT, convw, u); }
            } else {
                for (int i = blockIdx.x; i < NTOK / 64; i += G) att::pc_unit(PROJ, CAT, convw, (i >> 7) * 132 + 4 + (i & 127));
            }
            }
            SEAM(pb + 2);
        }
        if (IN(pb + 3)) { PHASE_REP(pb + 3) {
            pg8::Gemm g{CAT, (const bf16_t*)(ws + WS_WOUT + (size_t)l * SZ_WOUT), DM, 0, DM / 64};
            pg8::StaticOrder S; S.init(NPAN - 2, DM / 256, G, (int)blockIdx.x, 1);
            pg8::EpiResid E{X, a.in[I_X], a.in[I_CTX], modl + 2 * DM, l == 0 ? 1 : 0, rep_ ? (unsigned short*)(ws + WS_END) : X};
            pg8::gemm_phase<pg8::EpiResid, pg8::StaticOrder, false, true>(lds, g, S, E, nullptr);
            if (l == 0) {
                pg8::Gemm g2{CAT, (const bf16_t*)(ws + WS_WOUT), DM, 0, 8};
                pg8::CtxSplitOrder<4> S2{G, (int)blockIdx.x, 8 * 64 * 2};
                pg8::EpiPart E2{(unsigned short*)(ws + WS_PART)};
                pg8::gemm_phase<pg8::EpiPart, pg8::CtxSplitOrder<4>, false, true>(lds, g2, S2, E2, nullptr);
            }
            } SEAM(pb + 3);
        }
        if (l == 0) {
            if (IN(pb + 4)) { PHASE_REP(pb + 4) { norm_phase<false, true>(a, lds, G, a.in[I_NFFN], modl, 3, 4, false, nullptr, (const unsigned short*)(ws + WS_PART), MOD + 2 * 12288 + 2 * DM, 4, true); __syncthreads(); quant_dense_up(a, lds, G); } SEAM(pb + 4); }
            if (IN(pb + 6)) { PHASE_REP(pb + 6) {
                pg8::Gemm g{XN, (const bf16_t*)(ws + WS_WGU), DM / 2, 0, DM / 128};
                pg8::StaticOrder S; S.init(NPAN, NGU / 256, G, (int)blockIdx.x, 0);
                pg8::EpiSwigluI8 E{HID, (const float*)(ws + WS_ROWSC), (const float*)(ws + WS_COLSC)};
                pg8::gemm_phase<pg8::EpiSwigluI8, pg8::StaticOrder, false, true>(lds, g, S, E, nullptr);

                } SEAM(pb + 6);
            }
            if (IN(pb + 7)) { PHASE_REP(pb + 7) {
                pg8::Gemm g{HID, (const bf16_t*)(ws + WS_WD), DFF, 0, DFF / 64};
                pg8::StaticOrder S; S.init(NPAN - 2, DM / 256, G, (int)blockIdx.x, 1);
                pg8::EpiResid E{X, a.in[I_X], a.in[I_CTX], modl + 5 * DM, 0, rep_ ? (unsigned short*)(ws + WS_END) : X};
                pg8::gemm_phase<pg8::EpiResid, pg8::StaticOrder, false, true, false, true>(lds, g, S, E, nullptr);
                pg8::Gemm g2{HID, (const bf16_t*)(ws + WS_WD), DFF, 0, 8};
                pg8::CtxSplitOrder<14> S2{G, (int)blockIdx.x, 8 * 256 * 64 * 2};
                pg8::EpiPart E2{(unsigned short*)(ws + WS_PART)};
                pg8::gemm_phase<pg8::EpiPart, pg8::CtxSplitOrder<14>, false, true, false, true>(lds, g2, S2, E2, nullptr);
                } SEAM(pb + 7);
            }
        } else {
            if (IN(pb + 4)) { PHASE_REP(pb + 4) { norm_phase<true>(a, lds, G, a.in[I_NFFN] + DM, modl, 3, 4, false, a.in[I_ROUTER], nullptr, nullptr, 0, false); } SEAM(pb + 4); }
            if (IN(pb + 5)) { slot_phase(a, lds, G); SEAM(pb + 5); }
            if (IN(pb + 6)) { PHASE_REP(pb + 6) {
                const int* TL = (const int*)(ws + WS_TILES);
                pg8::Gemm g{XN, (const bf16_t*)(ws + WS_WGU + SZ_WGU), DM / 2, SZ_WGU8, DM / 128};
                pg8::StaticOrder S; S.init(TL[0], NGU / 256, G, (int)blockIdx.x, 0);
#pragma unroll
                for (int e = 0; e < 8; ++e) S.ts[e] = TL[1 + e];
                pg8::EpiSwiglu8 E{(unsigned char*)HID, 1.0f / WSC_UP, HSC};
                pg8::gemm_phase<pg8::EpiSwiglu8, pg8::StaticOrder, true, true, true>(lds, g, S, E, (const int*)(ws + WS_ROWTOK));
                } SEAM(pb + 6);
            }
            if (IN(pb + 7)) { PHASE_REP(pb + 7) {
                const int* TL = (const int*)(ws + WS_TILES);
                pg8::Gemm g{HID, (const bf16_t*)(ws + WS_WD + SZ_WD), DFF / 2, SZ_WD8, DFF / 128};
                const int nmain = TL[0] < 128 ? TL[0] : 128, ntail = (TL[0] - nmain) * (DM / 256) * 2;
                pg8::StaticOrder S; S.init(nmain, DM / 256, G, (int)blockIdx.x, 0);
#pragma unroll
                for (int e = 0; e < 8; ++e) S.ts[e] = TL[1 + e];
                pg8::EpiMoeDown E{FP, (const int*)(ws + WS_ROWDST), (const float*)(ws + WS_ROWP), 1.0f / (WSC_DN * HSC), (bf16_t*)(ws + WS_FP2)};
                pg8::gemm_phase<pg8::EpiMoeDown, pg8::StaticOrder, false, true, true>(lds, g, S, E, nullptr);
                GRIDBAR();
                if ((int)blockIdx.x < ntail) {
                    pg8::TailSplitOrder S2; S2.S.init(TL[0] - nmain, 2 * (DM / 256), ntail, (int)blockIdx.x, 0); S2.S.pm0 = nmain; S2.kob = DFF / 2;
#pragma unroll
                    for (int e = 0; e < 8; ++e) S2.S.ts[e] = TL[1 + e];
                    pg8::Gemm g2 = g; g2.nt = DFF / 128 / 2;
                    pg8::gemm_phase<pg8::EpiMoeDown, pg8::TailSplitOrder, false, true, true>(lds, g2, S2, E, nullptr);
                } else final_phase(a, G - ntail, (int)blockIdx.x - ntail, 0);
                } SEAM(pb + 7);
            }
        }
        }
    if (IN(17)) { PHASE_REP(17) { final_phase(a, G, (int)blockIdx.x, 1); } }
#undef IN
#undef SEAM
#undef GRIDBAR
}

extern "C" void kernel_launch(void* const* d_in, const int* in_sizes, int n_in, void* d_out, int out_size, void* d_ws, size_t ws_size, hipStream_t stream) {
    static int grid = 0;
    if (grid == 0) {
        if (n_in != 23 || in_sizes[0] != NB * SEQ * DM || out_size != NB * SEQ * DM || ws_size < WS_END) {
            fprintf(stderr, "kernel_launch: unexpected shapes: n_in %d in0 %d out %d ws %zu (need %zu); nothing launched\n", n_in, n_in > 0 ? in_sizes[0] : -1, out_size, ws_size, (size_t)WS_END); grid = -1; return; }
        int dev = 0, cus = 0, per_cu = 0;
        if (hipGetDevice(&dev) != hipSuccess || hipDeviceGetAttribute(&cus, hipDeviceAttributeMultiprocessorCount, dev) != hipSuccess) { grid = -1; return; }
        if (hipFuncSetAttribute((const void*)mk_fwd, hipFuncAttributeMaxDynamicSharedMemorySize, LDS_BYTES) != hipSuccess) { fprintf(stderr, "kernel_launch: hipFuncSetAttribute failed\n"); grid = -1; return; }
        if (hipOccupancyMaxActiveBlocksPerMultiprocessor(&per_cu, (const void*)mk_fwd, NWAVES * 64, LDS_BYTES) != hipSuccess || per_cu < 1)
            fprintf(stderr, "kernel_launch: note: occupancy query reports %d workgroups per CU\n", per_cu);
        (void)hipGetLastError();
        grid = cus;
    }
    if (grid < 0) return;
    if (hipMemsetAsync((char*)d_ws + WS_CTL, 0, CTL_ZERO_BYTES, stream) != hipSuccess) return;
    Args a{};
    for (int i = 0; i < 23; ++i) a.in[i] = (const float*)d_in[i];
    a.out = (float*)d_out; a.ws = (unsigned char*)d_ws;
#if MK_PER_PHASE
    for (int p = 0; p < N_PHASES; ++p) { if (p == 6) continue; a.ph_lo = p; a.ph_hi = p + 1; hipLaunchKernelGGL(mk_fwd, dim3(grid), dim3(NWAVES * 64), LDS_BYTES, stream, a); }
#else
    a.ph_lo = 0; a.ph_hi = N_PHASES;
    hipLaunchKernelGGL(mk_fwd, dim3(grid), dim3(NWAVES * 64), LDS_BYTES, stream, a);
#endif
    const hipError_t le = hipPeekAtLastError();
    if (le != hipSuccess) fprintf(stderr, "kernel_launch: launch failed: %s\n", hipGetErrorName(le));
}
```

```cpp
#include <hip/hip_runtime.h>
#include <cstdio>
#include <cstdint>

#define LAS __attribute__((address_space(3)))
#define GAS __attribute__((address_space(1)))
typedef unsigned short bf16_t;
typedef short bf16x8 __attribute__((ext_vector_type(8)));
typedef short s16x4 __attribute__((ext_vector_type(4)));
typedef float f32x4 __attribute__((ext_vector_type(4)));
typedef float f32x2 __attribute__((ext_vector_type(2)));
typedef unsigned u32x4 __attribute__((ext_vector_type(4)));
typedef unsigned u32x2 __attribute__((ext_vector_type(2)));

constexpr int DM = 2048, NB = 2, SEQ = 8192, CTXL = 256, GRW = 64, GRH = 128, HD = 64;
constexpr int RPB = CTXL + SEQ;
constexpr int MROWS = NB * RPB;
constexpr int NPAN = MROWS / 256;
constexpr int DIN = 4352, DFF = 7168, NGU = 2 * DFF;
constexpr int NEXP = 8, NTOK = NB * SEQ;
constexpr int MAXSLOT = 2 * NTOK + NEXP * 256, MAXTILES = MAXSLOT / 256;
constexpr int C_QA = 0, C_KA = 512, C_VA = 1024, C_UB = 1536, C_GB = 2048, C_GC = 2560, C_XV = 3072, C_QD = 3584, C_KD = 4096, C_VD = 4224;
constexpr float EPS = 1e-6f;
constexpr float LOG2E = 1.4426950408889634f;
constexpr float QSCALE = 0.125f * LOG2E;

constexpr size_t MiB = 1u << 20;
constexpr size_t WS_CTL = 0, CTL_ZERO_BYTES = 1 * MiB;
constexpr size_t WS_MOD = 1 * MiB;
constexpr size_t WS_ROPE = 1 * MiB + 512 * 1024;
constexpr size_t WS_ROUTE = 2 * MiB;
constexpr size_t WS_SLOTS = 1 * MiB + 768 * 1024;
constexpr size_t WS_TAILF = 2 * MiB + 384 * 1024;
constexpr size_t WS_CNT = 2 * MiB + 512 * 1024;
constexpr size_t WS_ROWTOK = 3 * MiB;
constexpr size_t WS_ROWDST = 3 * MiB + 256 * 1024;
constexpr size_t WS_ROWP = 3 * MiB + 512 * 1024;
constexpr size_t WS_TILES = 3 * MiB + 768 * 1024;
constexpr size_t WS_WIN = 4 * MiB;
constexpr size_t SZ_WIN = (size_t)DIN * DM * 2;
constexpr size_t WS_WOUT = WS_WIN + 2 * SZ_WIN;
constexpr size_t SZ_WOUT = (size_t)DM * DM * 2;
constexpr size_t WS_WGU = WS_WOUT + 2 * SZ_WOUT;
constexpr size_t SZ_WGU = (size_t)NGU * DM * 2;
constexpr size_t SZ_WGU8 = (size_t)NGU * DM, SZ_WD8 = (size_t)DM * DFF;
constexpr float WSC_UP = 32.f, WSC_DN = 64.f, HSC = 4.f;
constexpr size_t WS_FP2 = WS_WGU + 32 * MiB;
constexpr size_t WS_WD = WS_WGU + 9 * SZ_WGU;
constexpr size_t SZ_WD = (size_t)DM * DFF * 2;
constexpr size_t WS_X = WS_WD + 9 * SZ_WD;
constexpr size_t SZ_X = (size_t)MROWS * DM * 4;
constexpr size_t WS_XN = WS_X + SZ_X;
constexpr size_t SZ_XN = (size_t)MROWS * DM * 2;
constexpr size_t WS_R = WS_XN + SZ_XN;
constexpr size_t WS_PROJ = WS_R;
constexpr size_t SZ_PROJ = (size_t)MROWS * DIN * 2;
constexpr size_t WS_CAT = WS_PROJ + SZ_PROJ;
constexpr size_t WS_HID = WS_R;
constexpr size_t SZ_HID = (size_t)MAXSLOT * DFF * 2;
constexpr size_t WS_FP = WS_HID + SZ_HID;
constexpr size_t SZ_FP = (size_t)2 * NTOK * DM * 2;
constexpr size_t WS_END = WS_FP + SZ_FP;
constexpr size_t WS_PART = WS_R + 232 * MiB;
static_assert(WS_PART >= WS_R + (size_t)MROWS * DFF * 2 && WS_PART >= WS_CAT + SZ_XN && WS_PART + (size_t)14 * 512 * DM * 4 <= WS_FP, "PART placement");
static_assert(WS_CAT + SZ_XN <= WS_FP, "overlay");
static_assert(WS_WIN % 256 == 0 && WS_X % 256 == 0 && WS_R % 256 == 0, "align");
constexpr int CW_BAR = 4096;
constexpr int CW_COLMAX = 32768;
constexpr int CW_COLMAX_IN = 49152;
constexpr size_t WS_COLSC_IN = 1 * MiB + 640 * 1024;
constexpr size_t WS_COLSC = 3 * MiB + 832 * 1024;
constexpr size_t WS_ROWSC = 3 * MiB + 896 * 1024;

#define RLX_AGENT __ATOMIC_RELAXED, __HIP_MEMORY_SCOPE_AGENT
__device__ __forceinline__ unsigned f2bf(float f) { unsigned u = __builtin_bit_cast(unsigned, f); return (u + 0x7fffu + ((u >> 16) & 1u)) >> 16; }
__device__ __forceinline__ unsigned pk2(float lo, float hi) { return f2bf(lo) | (f2bf(hi) << 16); }
__device__ __forceinline__ float bf2f(unsigned short h) { return __builtin_bit_cast(float, (unsigned)h << 16); }
__device__ __forceinline__ float bflo(unsigned w) { return __builtin_bit_cast(float, w << 16); }
__device__ __forceinline__ float bfhi(unsigned w) { return __builtin_bit_cast(float, w & 0xffff0000u); }
typedef _Float16 f16x2_t __attribute__((ext_vector_type(2)));
__device__ __forceinline__ unsigned pkh2(float lo, float hi) { const f16x2_t h = {(_Float16)lo, (_Float16)hi}; return __builtin_bit_cast(unsigned, h); }
__device__ __forceinline__ f32x4 unpk_h4(unsigned w0, unsigned w1) { const f16x2_t a = __builtin_bit_cast(f16x2_t, w0), b = __builtin_bit_cast(f16x2_t, w1); return (f32x4){(float)a[0], (float)a[1], (float)b[0], (float)b[1]}; }
__device__ __forceinline__ unsigned cvt_pk_bf16(float lo, float hi) { unsigned r; asm volatile("v_cvt_pk_bf16_f32 %0, %1, %2" : "=v"(r) : "v"(lo), "v"(hi)); return r; }
__device__ __forceinline__ float xadd16(float v) { const auto r = __builtin_amdgcn_permlane16_swap(__float_as_uint(v), __float_as_uint(v), false, false); return __uint_as_float(r[0]) + __uint_as_float(r[1]); }
__device__ __forceinline__ float xadd32(float v) { const auto r = __builtin_amdgcn_permlane32_swap(__float_as_uint(v), __float_as_uint(v), false, false); return __uint_as_float(r[0]) + __uint_as_float(r[1]); }
__device__ __forceinline__ float fmax2(float a, float b) { return __builtin_amdgcn_fmed3f(a, b, __builtin_inff()); }
__device__ __forceinline__ float xmax16(float v) { const auto r = __builtin_amdgcn_permlane16_swap(__float_as_uint(v), __float_as_uint(v), false, false); return fmax2(__uint_as_float(r[0]), __uint_as_float(r[1])); }
__device__ __forceinline__ float xmax32(float v) { const auto r = __builtin_amdgcn_permlane32_swap(__float_as_uint(v), __float_as_uint(v), false, false); return fmax2(__uint_as_float(r[0]), __uint_as_float(r[1])); }
__device__ __forceinline__ float wave_sum(float v) {
#pragma unroll
    for (int o = 1; o < 16; o <<= 1) v += __shfl_xor(v, o);
    return xadd32(xadd16(v));
}
__device__ __forceinline__ float fast_silu(float x) { return x * __builtin_amdgcn_rcpf(1.0f + __builtin_amdgcn_exp2f(-x * LOG2E)); }
__device__ __forceinline__ int opaque_tid() { int t = threadIdx.x; asm volatile("" : "+v"(t)); return t; }
__device__ __forceinline__ const float* in_row(const float* x, const float* ctx, int m) {
    const int b = m / RPB, r = m - b * RPB;
    return r < CTXL ? ctx + ((size_t)b * CTXL + r) * DM : x + ((size_t)b * SEQ + (r - CTXL)) * DM;
}
namespace pg8 {
constexpr int BM = 256, BK = 64, HALF = 128, HTB = HALF * BK * 2  , STAGE_BYTES = 8 * HTB, NXCD = 8, WGM = 8;
__host__ __device__ __forceinline__ int lds_byte(int r, int c) { const int st = (r >> 4) * 2 + (c >> 5), rr = r & 15, cc = c & 31, ob = rr * 64 + cc * 2; return st * 1024 + (ob ^ (((ob >> 9) & 1) << 5)); }
__host__ __device__ __forceinline__ void stage_rc(int b, int& R, int& C) { const int st = b / 1024, sb = b % 1024, swz = sb ^ (((sb >> 9) & 1) << 5); R = (st >> 1) * 16 + swz / 64; C = (st & 1) * 32 + (swz % 64) / 2; }
__host__ __device__ __forceinline__ int perm32(int rho) { const int n = rho >> 4, i = rho & 15; return 8 * (i >> 2) + 4 * n + (i & 3); }

typedef int v4i_t __attribute__((ext_vector_type(4))); typedef int v8i_t __attribute__((ext_vector_type(8)));
__device__ __forceinline__ v8i_t cat8(bf16x8 lo, bf16x8 hi) { return __builtin_shufflevector(__builtin_bit_cast(v4i_t, lo), __builtin_bit_cast(v4i_t, hi), 0, 1, 2, 3, 4, 5, 6, 7); }
struct Unit { int pm, pn, e, ko; };
struct Gemm { const bf16_t* A; const bf16_t* Bt; int K; size_t bstride; int nt; };

struct StaticOrder {
    int nM, nN, nwg, G, c, skipctx, wrap, pm0, wgm; int ts[8];
    __device__ void init(int nM_, int nN_, int G_, int c_, int skip_) { nM = nM_; nN = nN_; nwg = nM * nN; G = G_; c = c_; skipctx = skip_; wrap = 0; pm0 = 0; wgm = WGM;
#pragma unroll
        for (int e = 0; e < 8; ++e) ts[e] = 0x7fffffff; ts[0] = 0; }
    __device__ bool next(int i, Unit& u) const {
        const long L = (long)i * G + c; if (L >= nwg) return false;
        int wgid = (int)L; { const int q = nwg / NXCD, r = nwg % NXCD, xcd = wgid % NXCD, off = wgid / NXCD; wgid = (xcd < r ? xcd * (q + 1) : r * (q + 1) + (xcd - r) * q) + off; }
        const int nig = wgm * nN, gid = wgid / nig, fm = gid * wgm, gsz = (nM - fm) < wgm ? (nM - fm) : wgm;
        int pm = pm0 + fm + ((wgid % nig) % gsz); u.pn = (wgid % nig) / gsz;
        int e = 0;
#pragma unroll
        for (int k = 1; k < 8; ++k) e += (pm >= ts[k]) ? 1 : 0;
        u.e = e; u.ko = 0;
        if (skipctx) pm = pm + 1 + (pm >= 32 ? 1 : 0);
        if (wrap) pm = (pm % wrap) + 1;
        u.pm = pm; return true;
    }
};

struct TailSplitOrder {
    StaticOrder S; int kob;
    __device__ bool next(int i, Unit& u) const { if (!S.next(i, u)) return false; const int kh = u.pn >> 3; u.pn &= 7; u.ko = kh * kob; return true; }
};
template <int NS>
struct CtxSplitOrder {
    int G, c, kob;
    __device__ bool next(int i, Unit& u) const { const int L = i * G + c; if (L >= 16 * NS) return false; const int ks = L % NS, tile = L / NS; u.pn = tile & 7; u.pm = (tile >> 3) * 33; u.e = ks; u.ko = ks * kob; return true; }
};
#define PG8_SA(b, h) (((b) * 2 + (h)) * HTB)
#define PG8_SB(b, h) ((4 + (b) * 2 + (h)) * HTB)
#define PG8_STAGE(bufoff, gbase, voff) do { _Pragma("unroll") for (int _i = 0; _i < 2; ++_i) \
        __builtin_amdgcn_global_load_lds((const unsigned*)((const char*)(gbase) + (voff)[_i]), (LAS unsigned*)(lds + (bufoff) + ldsw + _i * 8192), 16, 0, 0); } while (0)
#define PG8_LDA(dst, b, h) do { _Pragma("unroll") for (int m = 0; m < 4; ++m) _Pragma("unroll") for (int k = 0; k < 2; ++k) dst[m][k] = *(const LAS bf16x8*)(lds + PG8_SA(b, h) + aoff + m * 2048 + k * 1024); } while (0)
#define PG8_LDB(dst, b, h) do { _Pragma("unroll") for (int n = 0; n < 2; ++n) _Pragma("unroll") for (int k = 0; k < 2; ++k) dst[n][k] = *(const LAS bf16x8*)(lds + PG8_SB(b, h) + boff + n * 2048 + k * 1024); } while (0)
#define PG8_MMA(ai, bj, At, Bt) do { __builtin_amdgcn_s_setprio(1); _Pragma("unroll") for (int m = 0; m < 4; ++m) _Pragma("unroll") for (int n = 0; n < 2; ++n) _Pragma("unroll") for (int k = 0; k < 2; ++k) \
        acc[ai][bj][m][n] = __builtin_amdgcn_mfma_f32_16x16x32_bf16(Bt[n][k], At[m][k], acc[ai][bj][m][n], 0, 0, 0); __builtin_amdgcn_s_setprio(0); } while (0)
#define PG8_MMA8(ai, bj, At, Bt) do { __builtin_amdgcn_s_setprio(1); _Pragma("unroll") for (int m = 0; m < 4; ++m) _Pragma("unroll") for (int n = 0; n < 2; ++n) \
        asm volatile("v_mfma_scale_f32_16x16x128_f8f6f4 %0, %1, %2, %0, %3, %3 op_sel_hi:[0,0,0]" : "+v"(acc[ai][bj][m][n]) : "v"(cat8(Bt[n][0], Bt[n][1])), "v"(cat8(At[m][0], At[m][1])), "v"(one_scale)); __builtin_amdgcn_s_setprio(0); } while (0)
#define PG8_MMAI(ai, bj, At, Bt) do { __builtin_amdgcn_s_setprio(1); _Pragma("unroll") for (int m = 0; m < 4; ++m) _Pragma("unroll") for (int n = 0; n < 2; ++n) _Pragma("unroll") for (int k = 0; k < 2; ++k) \
        acc[ai][bj][m][n] = __builtin_bit_cast(f32x4, __builtin_amdgcn_mfma_i32_16x16x64_i8(__builtin_bit_cast(v4i_t, Bt[n][k]), __builtin_bit_cast(v4i_t, At[m][k]), __builtin_bit_cast(v4i_t, acc[ai][bj][m][n]), 0, 0, 0)); __builtin_amdgcn_s_setprio(0); } while (0)
#define PG8_MM(ai, bj, At, Bt) do { if constexpr (F8) PG8_MMA8(ai, bj, At, Bt); else if constexpr (Epi::I8) PG8_MMAI(ai, bj, At, Bt); else PG8_MMA(ai, bj, At, Bt); } while (0)
#define PG8_WAIT_V(n) asm volatile("s_waitcnt vmcnt(" #n ")" ::: "memory")
#define PG8_WAIT_L(n) asm volatile("s_waitcnt lgkmcnt(" #n ")" ::: "memory")
#define PG8_BAR __builtin_amdgcn_s_barrier()
#define PG8_SCHED __builtin_amdgcn_sched_barrier(0)

template <class Epi, class Sched, bool GATHER, bool ALIGN_EPI, bool F8 = false, bool BLK = false>
__device__ __forceinline__ void gemm_phase(LAS unsigned char* lds, const Gemm g, const Sched& S, const Epi& E, const int* __restrict__ rowtok) {
    const int tid = opaque_tid(), wid = __builtin_amdgcn_readfirstlane(tid >> 6), lane = tid & 63, wr = wid >> 2, wc = wid & 3, fr = lane & 15, fq = lane >> 4;
    const int K = g.K, nt = g.nt;
    unsigned voffB[2]; int RA[2], CA[2];
#pragma unroll
    for (int i = 0; i < 2; ++i) { int R, C; stage_rc(tid * 16 + i * 8192, R, C); const int Rb = Epi::PERM ? ((R & ~31) + perm32(R & 31)) : R;
        RA[i] = R; CA[i] = C; voffB[i] = (unsigned)(Rb * (BLK ? BK : K) + C) * 2u; }
    const size_t kstep = BLK ? (size_t)(BM * BK * 2) : (size_t)(BK * 2);
    const size_t hstep = BLK ? (size_t)(HALF * BK * 2) : (size_t)HALF * K * 2;
    const size_t tstep = (size_t)BM * K * 2;
    const unsigned ldsw = (unsigned)wid * 1024u;
    const int aoff = lds_byte(wr * 64 + fr, fq * 8), boff = lds_byte(wc * 32 + fr, fq * 8);
#define PG8_SETA(v, u) do { _Pragma("unroll") for (int _h = 0; _h < 2; ++_h) _Pragma("unroll") for (int _i = 0; _i < 2; ++_i) { \
        int _row = (u).pm * BM + _h * HALF + RA[_i]; if constexpr (GATHER) _row = rowtok[_row]; \
        v[_h][_i] = BLK ? (unsigned)((_row >> 8) * (BM * K) + (_row & 255) * BK + CA[_i]) * 2u : (unsigned)(_row * K + CA[_i]) * 2u; } } while (0)
    Unit cur, nxt, nn; int ui = 0;
    if (!S.next(0, cur)) return;
    bool has_next = S.next(1, nxt);
    unsigned vA[2][2], vN[2][2];
    PG8_SETA(vA, cur);
    if (has_next) PG8_SETA(vN, nxt); else { _Pragma("unroll") for (int h = 0; h < 2; ++h) _Pragma("unroll") for (int i = 0; i < 2; ++i) vN[h][i] = vA[h][i]; }
    f32x4 acc[2][2][4][2];
#pragma unroll
    for (int a = 0; a < 2; ++a)
#pragma unroll
        for (int b = 0; b < 2; ++b)
#pragma unroll
            for (int m = 0; m < 4; ++m)
#pragma unroll
                for (int n = 0; n < 2; ++n) acc[a][b][m][n] = (f32x4){0.f, 0.f, 0.f, 0.f};
    bf16x8 At[4][2], B0[2][2], B1[2][2];
    const int one_scale = 0x7f7f7f7f;
    const char* cA = (const char*)g.A + cur.ko;
    const char* cB = (const char*)g.Bt + (size_t)cur.e * g.bstride + (size_t)cur.pn * tstep + cur.ko;
    PG8_STAGE(PG8_SB(0, 0), cB, voffB); PG8_STAGE(PG8_SB(0, 1), cB + hstep, voffB); PG8_STAGE(PG8_SA(0, 0), cA, vA[0]); PG8_STAGE(PG8_SA(0, 1), cA, vA[1]);
    if (wr == 1) PG8_BAR;
    PG8_WAIT_V(2); PG8_BAR;
    PG8_STAGE(PG8_SB(1, 0), cB + kstep, voffB); PG8_STAGE(PG8_SA(1, 0), cA + kstep, vA[0]); PG8_STAGE(PG8_SB(1, 1), cB + hstep + kstep, voffB);
    PG8_WAIT_V(6); PG8_BAR;
    for (;;) {
        const char* nB = has_next ? (const char*)g.Bt + (size_t)nxt.e * g.bstride + (size_t)nxt.pn * tstep + nxt.ko : cB;
        const char* nA = has_next ? (const char*)g.A + nxt.ko : cA;
        for (int t = 0; t < nt; t += 2) {
            const bool last = (t == nt - 2);
            const char* a1 = cA + (size_t)(t + 1) * kstep;
            const char* a2 = last ? nA : cA + (size_t)(t + 2) * kstep; const char* b2 = last ? nB : cB + (size_t)(t + 2) * kstep;
            const char* a3 = a2 + kstep; const char* b3 = b2 + kstep;
            unsigned v2[2][2];
#pragma unroll
            for (int h = 0; h < 2; ++h)
#pragma unroll
                for (int i = 0; i < 2; ++i) v2[h][i] = last ? vN[h][i] : vA[h][i];
            PG8_LDB(B0, 0, 0); PG8_LDB(B1, 0, 1); PG8_SCHED; PG8_LDA(At, 0, 0); PG8_STAGE(PG8_SA(1, 1), a1, vA[1]);
            PG8_WAIT_V(8); PG8_WAIT_L(0); PG8_BAR; PG8_MM(0, 0, At, B0); PG8_MM(0, 1, At, B1); PG8_BAR; PG8_SCHED;
            PG8_LDA(At, 0, 1); PG8_STAGE(PG8_SB(0, 0), b2, voffB); PG8_STAGE(PG8_SB(0, 1), b2 + hstep, voffB); PG8_STAGE(PG8_SA(0, 0), a2, v2[0]);
            PG8_WAIT_V(8); PG8_WAIT_L(0); PG8_BAR; PG8_MM(1, 0, At, B0); PG8_MM(1, 1, At, B1); PG8_BAR; PG8_SCHED;
            PG8_LDB(B0, 1, 0); PG8_LDB(B1, 1, 1); PG8_SCHED; PG8_LDA(At, 1, 0); PG8_STAGE(PG8_SA(0, 1), a2, v2[1]);
            PG8_WAIT_V(8); PG8_WAIT_L(0); PG8_BAR; PG8_MM(0, 0, At, B0); PG8_MM(0, 1, At, B1); PG8_BAR; PG8_SCHED;
            PG8_LDA(At, 1, 1); PG8_STAGE(PG8_SB(1, 0), b3, voffB); PG8_STAGE(PG8_SB(1, 1), b3 + hstep, voffB); PG8_STAGE(PG8_SA(1, 0), a3, v2[0]);
            PG8_WAIT_V(8); PG8_WAIT_L(0); PG8_BAR; PG8_MM(1, 0, At, B0); PG8_MM(1, 1, At, B1); PG8_BAR; PG8_SCHED;
        }
        if constexpr (ALIGN_EPI) { if (wr == 0) PG8_BAR; }
        if constexpr (F8) { asm volatile("s_nop 15\n\ts_nop 15" ::: "memory");
            _Pragma("unroll") for (int a_ = 0; a_ < 2; ++a_) _Pragma("unroll") for (int b_ = 0; b_ < 2; ++b_) _Pragma("unroll") for (int m_ = 0; m_ < 4; ++m_) _Pragma("unroll") for (int n_ = 0; n_ < 2; ++n_) asm volatile("" : "+v"(acc[a_][b_][m_][n_])); }
        E(acc, cur, wr, wc, fr, fq);
        if (!has_next) break;
#pragma unroll
        for (int a = 0; a < 2; ++a)
#pragma unroll
            for (int b = 0; b < 2; ++b)
#pragma unroll
                for (int m = 0; m < 4; ++m)
#pragma unroll
                    for (int n = 0; n < 2; ++n) acc[a][b][m][n] = (f32x4){0.f, 0.f, 0.f, 0.f};
        cur = nxt; cB = nB; cA = nA; ++ui;
#pragma unroll
        for (int h = 0; h < 2; ++h)
#pragma unroll
            for (int i = 0; i < 2; ++i) vA[h][i] = vN[h][i];
        has_next = S.next(ui + 1, nn);
        if (has_next) { nxt = nn; PG8_SETA(vN, nxt); }
        if constexpr (ALIGN_EPI) { if (wr == 1) PG8_BAR; }
    }
    PG8_WAIT_V(0);
    if constexpr (!ALIGN_EPI) { if (wr == 0) PG8_BAR; }
    PG8_BAR;
#undef PG8_SETA
}


struct EpiProj {
    static constexpr bool PERM = true, IDEMP = true, I8 = false;
    bf16_t* P; const f32x2* rope;
    __device__ __forceinline__ void operator()(const f32x4 (&acc)[2][2][4][2], const Unit& u, int wr, int wc, int fr, int fq) const {
        const int pn = u.pn; const bool ctxp = (u.pm % 33) == 0;
        const int row0 = u.pm * BM + wr * 64 + fr;
#pragma unroll
        for (int bj = 0; bj < 2; ++bj) {
            const int cN = pn * BM + bj * HALF + wc * 32 + 8 * fq;
            const bool isrope = (pn == 14) || (pn == 15) || (pn == 16 && bj == 0);
            const float sc = (pn < 2 || pn == 14 || pn == 15) ? QSCALE : 1.0f;
            if (!isrope) {
#pragma unroll
                for (int ai = 0; ai < 2; ++ai)
#pragma unroll
                    for (int m = 0; m < 4; ++m) { const f32x4 v0 = acc[ai][bj][m][0] * sc, v1 = acc[ai][bj][m][1] * sc;
                        u32x4 w; w.x = cvt_pk_bf16(v0[0], v0[1]); w.y = cvt_pk_bf16(v0[2], v0[3]); w.z = cvt_pk_bf16(v1[0], v1[1]); w.w = cvt_pk_bf16(v1[2], v1[3]);
                        *(u32x4*)(P + (size_t)(row0 + ai * HALF + m * 16) * DIN + cN) = w; }
            } else {
                const int hrel = (wc & 1) * 32 + 8 * fq, hb = cN - hrel, a = hrel >> 3;
#pragma unroll
                for (int ai = 0; ai < 2; ++ai)
#pragma unroll
                    for (int m = 0; m < 4; ++m) { const int row = row0 + ai * HALF + m * 16;
                        f32x4 x1 = acc[ai][bj][m][0], x2 = acc[ai][bj][m][1], o1, o2;
                        if (!ctxp) { const int t = (row % RPB) - CTXL; const int pos = (wc & 1) ? (t & 63) : (t >> 6);
                            const f32x4* cs = (const f32x4*)(rope + pos * 16 + 4 * fq); const f32x4 c01 = cs[0], c23 = cs[1];
                            o1[0] = x1[0] * c01[0] - x2[0] * c01[1]; o2[0] = x1[0] * c01[1] + x2[0] * c01[0];
                            o1[1] = x1[1] * c01[2] - x2[1] * c01[3]; o2[1] = x1[1] * c01[3] + x2[1] * c01[2];
                            o1[2] = x1[2] * c23[0] - x2[2] * c23[1]; o2[2] = x1[2] * c23[1] + x2[2] * c23[0];
                            o1[3] = x1[3] * c23[2] - x2[3] * c23[3]; o2[3] = x1[3] * c23[3] + x2[3] * c23[2];
                        } else { o1 = x1; o2 = x2; }
                        o1 = o1 * sc; o2 = o2 * sc;
                        u32x2 w1, w2; w1.x = cvt_pk_bf16(o1[0], o1[1]); w1.y = cvt_pk_bf16(o1[2], o1[3]); w2.x = cvt_pk_bf16(o2[0], o2[1]); w2.y = cvt_pk_bf16(o2[2], o2[3]);
                        bf16_t* rp = P + (size_t)row * DIN + hb + 4 * a;
                        *(u32x2*)(rp) = w1; *(u32x2*)(rp + 32) = w2; }
            }
        }
    }
};
struct EpiProjI8 {
    static constexpr bool PERM = true, IDEMP = true, I8 = true;
    bf16_t* P; const f32x2* rope; const float* rowsc; const float* colsc;
    __device__ __forceinline__ void operator()(const f32x4 (&acc)[2][2][4][2], const Unit& u, int wr, int wc, int fr, int fq) const {
        const int pn = u.pn; const bool ctxp = (u.pm % 33) == 0;
        const int row0 = u.pm * BM + wr * 64 + fr;
        float rsv[2][4];
#pragma unroll
        for (int ai = 0; ai < 2; ++ai)
#pragma unroll
            for (int m = 0; m < 4; ++m) rsv[ai][m] = rowsc[row0 + ai * HALF + m * 16];
        f32x4 csv[2][2];
#pragma unroll
        for (int bj = 0; bj < 2; ++bj) { const int cN = pn * BM + bj * HALF + wc * 32 + 8 * fq; csv[bj][0] = *(const f32x4*)(colsc + cN); csv[bj][1] = *(const f32x4*)(colsc + cN + 4); }
        asm volatile("" ::: "memory");
#pragma unroll
        for (int bj = 0; bj < 2; ++bj) {
            const int cN = pn * BM + bj * HALF + wc * 32 + 8 * fq;
            const f32x4 cs0 = csv[bj][0], cs1 = csv[bj][1];
            const bool isrope = (pn == 14) || (pn == 15) || (pn == 16 && bj == 0);
            const float sc = (pn < 2 || pn == 14 || pn == 15) ? QSCALE : 1.0f;
            if (!isrope) {
#pragma unroll
                for (int ai = 0; ai < 2; ++ai)
#pragma unroll
                    for (int m = 0; m < 4; ++m) { const float rs = rsv[ai][m] * sc; f32x4 v0, v1;
                        _Pragma("unroll") for (int k = 0; k < 4; ++k) { v0[k] = (float)__float_as_int(acc[ai][bj][m][0][k]) * (rs * cs0[k]); v1[k] = (float)__float_as_int(acc[ai][bj][m][1][k]) * (rs * cs1[k]); }
                        u32x4 w; w.x = cvt_pk_bf16(v0[0], v0[1]); w.y = cvt_pk_bf16(v0[2], v0[3]); w.z = cvt_pk_bf16(v1[0], v1[1]); w.w = cvt_pk_bf16(v1[2], v1[3]);
                        *(u32x4*)(P + (size_t)(row0 + ai * HALF + m * 16) * DIN + cN) = w; }
            } else {
                const int hrel = (wc & 1) * 32 + 8 * fq, hb = cN - hrel, a = hrel >> 3;
#pragma unroll
                for (int ai = 0; ai < 2; ++ai) {
                    f32x4 rc01[4], rc23[4];
                    if (!ctxp) {
#pragma unroll
                        for (int m = 0; m < 4; ++m) { const int row = row0 + ai * HALF + m * 16; const int t = (row % RPB) - CTXL; const int pos = (wc & 1) ? (t & 63) : (t >> 6);
                            const f32x4* cs = (const f32x4*)(rope + pos * 16 + 4 * fq); rc01[m] = cs[0]; rc23[m] = cs[1]; } }
                    asm volatile("" ::: "memory");
#pragma unroll
                    for (int m = 0; m < 4; ++m) { const int row = row0 + ai * HALF + m * 16;
                        const float rs = rsv[ai][m]; f32x4 x1, x2, o1, o2;
                        _Pragma("unroll") for (int k = 0; k < 4; ++k) { x1[k] = (float)__float_as_int(acc[ai][bj][m][0][k]) * (rs * cs0[k]); x2[k] = (float)__float_as_int(acc[ai][bj][m][1][k]) * (rs * cs1[k]); }
                        if (!ctxp) { const f32x4 c01 = rc01[m], c23 = rc23[m];
                            o1[0] = x1[0] * c01[0] - x2[0] * c01[1]; o2[0] = x1[0] * c01[1] + x2[0] * c01[0];
                            o1[1] = x1[1] * c01[2] - x2[1] * c01[3]; o2[1] = x1[1] * c01[3] + x2[1] * c01[2];
                            o1[2] = x1[2] * c23[0] - x2[2] * c23[1]; o2[2] = x1[2] * c23[1] + x2[2] * c23[0];
                            o1[3] = x1[3] * c23[2] - x2[3] * c23[3]; o2[3] = x1[3] * c23[3] + x2[3] * c23[2];
                        } else { o1 = x1; o2 = x2; }
                        o1 = o1 * sc; o2 = o2 * sc;
                        u32x2 w1, w2; w1.x = cvt_pk_bf16(o1[0], o1[1]); w1.y = cvt_pk_bf16(o1[2], o1[3]); w2.x = cvt_pk_bf16(o2[0], o2[1]); w2.y = cvt_pk_bf16(o2[2], o2[3]);
                        bf16_t* rp = P + (size_t)row * DIN + hb + 4 * a;
                        *(u32x2*)(rp) = w1; *(u32x2*)(rp + 32) = w2; }
                }
            }
        }
    }
};
struct EpiResid {
    static constexpr bool PERM = true, IDEMP = false, I8 = false;
    unsigned short* X; const float* xin; const float* cin; const float* gate; int from_inputs; unsigned short* Xw;
    __device__ __forceinline__ void operator()(const f32x4 (&acc)[2][2][4][2], const Unit& u, int wr, int wc, int fr, int fq) const {
        const int b = u.pm / 33; const bool ctxp = (u.pm % 33) == 0; const float* gp = gate + (ctxp ? 2 : b) * 12288;
        const int col0 = u.pn * BM + wc * 32 + 8 * fq;
        f32x4 gv[2][2];
#pragma unroll
        for (int bj = 0; bj < 2; ++bj)
#pragma unroll
            for (int n = 0; n < 2; ++n) gv[bj][n] = *(const f32x4*)(gp + col0 + bj * HALF + 4 * n);
#pragma unroll
        for (int ai = 0; ai < 2; ++ai)
#pragma unroll
            for (int mp = 0; mp < 2; ++mp) {
                f32x4 r0[2][2], r1[2][2]; unsigned short* dst[2];
#pragma unroll
                for (int mm = 0; mm < 2; ++mm) { const int row = u.pm * BM + ai * HALF + wr * 64 + (2 * mp + mm) * 16 + fr;
                    const float* srcf = in_row(xin, cin, row); const unsigned short* srch = X + (size_t)row * DM; dst[mm] = Xw + (size_t)row * DM;
#pragma unroll
                    for (int bj = 0; bj < 2; ++bj) { const int c = col0 + bj * HALF;
                        if (from_inputs) { r0[mm][bj] = *(const f32x4*)(srcf + c); r1[mm][bj] = *(const f32x4*)(srcf + c + 4); }
                        else { const u32x4 w = *(const u32x4*)(srch + c); r0[mm][bj] = unpk_h4(w.x, w.y); r1[mm][bj] = unpk_h4(w.z, w.w); } } }
                asm volatile("" ::: "memory");
#pragma unroll
                for (int mm = 0; mm < 2; ++mm)
#pragma unroll
                    for (int bj = 0; bj < 2; ++bj) { const int c = col0 + bj * HALF, m = 2 * mp + mm;
                        const f32x4 o0 = r0[mm][bj] + gv[bj][0] * acc[ai][bj][m][0], o1 = r1[mm][bj] + gv[bj][1] * acc[ai][bj][m][1];
                        u32x4 ow; ow.x = pkh2(o0[0], o0[1]); ow.y = pkh2(o0[2], o0[3]); ow.z = pkh2(o1[0], o1[1]); ow.w = pkh2(o1[2], o1[3]);
                        *(u32x4*)(dst[mm] + c) = ow; }
                asm volatile("" ::: "memory");
            }
    }
};
struct EpiPart {
    static constexpr bool PERM = true, IDEMP = true, I8 = false;
    unsigned short* PART;
    __device__ __forceinline__ void operator()(const f32x4 (&acc)[2][2][4][2], const Unit& u, int wr, int wc, int fr, int fq) const {
        const int col0 = u.pn * BM + wc * 32 + 8 * fq; unsigned short* base = PART + ((size_t)u.e * 512 + (u.pm ? 256 : 0)) * DM;
#pragma unroll
        for (int ai = 0; ai < 2; ++ai)
#pragma unroll
            for (int m = 0; m < 4; ++m) { unsigned short* dst = base + (size_t)(ai * HALF + wr * 64 + m * 16 + fr) * DM + col0;
#pragma unroll
                for (int bj = 0; bj < 2; ++bj) { const f32x4 a0 = acc[ai][bj][m][0], a1 = acc[ai][bj][m][1];
                    u32x4 w; w.x = pkh2(a0[0], a0[1]); w.y = pkh2(a0[2], a0[3]); w.z = pkh2(a1[0], a1[1]); w.w = pkh2(a1[2], a1[3]);
                    *(u32x4*)(dst + bj * HALF) = w; } }
    }
};
struct EpiSwiglu {
    static constexpr bool PERM = true, IDEMP = true, I8 = false;
    bf16_t* H;
    __device__ __forceinline__ void operator()(const f32x4 (&acc)[2][2][4][2], const Unit& u, int wr, int wc, int fr, int fq) const {
        const int row0 = wr * 64 + fr; bf16_t* Hb = H + (size_t)u.pm * (BM * DFF) + (size_t)(2 * u.pn + (wc >> 1)) * (BM * BK) + (wc & 1) * 32 + 8 * fq;
#pragma unroll
        for (int ai = 0; ai < 2; ++ai)
#pragma unroll
            for (int m = 0; m < 4; ++m) { f32x4 h0, h1;
#pragma unroll
                for (int k = 0; k < 4; ++k) { h0[k] = fast_silu(acc[ai][0][m][0][k]) * acc[ai][1][m][0][k]; h1[k] = fast_silu(acc[ai][0][m][1][k]) * acc[ai][1][m][1][k]; }
                u32x4 w; w.x = cvt_pk_bf16(h0[0], h0[1]); w.y = cvt_pk_bf16(h0[2], h0[3]); w.z = cvt_pk_bf16(h1[0], h1[1]); w.w = cvt_pk_bf16(h1[2], h1[3]);
                *(u32x4*)(Hb + (row0 + ai * HALF + m * 16) * BK) = w; }
    }
};
struct EpiSwigluI8 {
    static constexpr bool PERM = true, IDEMP = true, I8 = true;
    bf16_t* H; const float* rowsc; const float* colsc;
    __device__ __forceinline__ void operator()(const f32x4 (&acc)[2][2][4][2], const Unit& u, int wr, int wc, int fr, int fq) const {
        const int row0 = wr * 64 + fr; bf16_t* Hb = H + (size_t)u.pm * (BM * DFF) + (size_t)(2 * u.pn + (wc >> 1)) * (BM * BK) + (wc & 1) * 32 + 8 * fq;
        const int cN = u.pn * BM + wc * 32 + 8 * fq;
        const f32x4 cg0 = *(const f32x4*)(colsc + cN), cg1 = *(const f32x4*)(colsc + cN + 4), cu0 = *(const f32x4*)(colsc + cN + HALF), cu1 = *(const f32x4*)(colsc + cN + HALF + 4);
        float rsv[2][4];
#pragma unroll
        for (int ai = 0; ai < 2; ++ai)
#pragma unroll
            for (int m = 0; m < 4; ++m) rsv[ai][m] = rowsc[u.pm * BM + row0 + ai * HALF + m * 16];
        asm volatile("" ::: "memory");
#pragma unroll
        for (int ai = 0; ai < 2; ++ai)
#pragma unroll
            for (int m = 0; m < 4; ++m) { const float rs = rsv[ai][m]; f32x4 h0, h1;
#pragma unroll
                for (int k = 0; k < 4; ++k) {
                    const float g0 = (float)__float_as_int(acc[ai][0][m][0][k]) * (rs * cg0[k]), u0 = (float)__float_as_int(acc[ai][1][m][0][k]) * (rs * cu0[k]);
                    const float g1 = (float)__float_as_int(acc[ai][0][m][1][k]) * (rs * cg1[k]), u1 = (float)__float_as_int(acc[ai][1][m][1][k]) * (rs * cu1[k]);
                    h0[k] = fast_silu(g0) * u0; h1[k] = fast_silu(g1) * u1;
                }
                u32x4 w; w.x = cvt_pk_bf16(h0[0], h0[1]); w.y = cvt_pk_bf16(h0[2], h0[3]); w.z = cvt_pk_bf16(h1[0], h1[1]); w.w = cvt_pk_bf16(h1[2], h1[3]);
                *(u32x4*)(Hb + (row0 + ai * HALF + m * 16) * BK) = w; }
    }
};
struct EpiMoeDown {
    static constexpr bool PERM = true, IDEMP = true, I8 = false;
    bf16_t* FP; const int* rowdst; const float* rowp; float sc; bf16_t* FP2;
    __device__ __forceinline__ void operator()(const f32x4 (&acc)[2][2][4][2], const Unit& u, int wr, int wc, int fr, int fq) const {
        const int col0 = u.pn * BM + wc * 32 + 8 * fq;
        int dstv[2][4]; float pv[2][4];
#pragma unroll
        for (int ai = 0; ai < 2; ++ai)
#pragma unroll
            for (int m = 0; m < 4; ++m) { const int slot = u.pm * BM + ai * HALF + wr * 64 + m * 16 + fr; const int d_ = rowdst[slot]; dstv[ai][m] = (u.ko != 0 && d_ >= 0) ? slot - 128 * BM : d_; pv[ai][m] = rowp[slot]; }
        asm volatile("" ::: "memory");
#pragma unroll
        for (int ai = 0; ai < 2; ++ai)
#pragma unroll
            for (int m = 0; m < 4; ++m) { const int dst = dstv[ai][m]; const float p = pv[ai][m] * sc;
                if (dst >= 0) { bf16_t* rp = (u.ko != 0 ? FP2 : FP) + (size_t)dst * DM + col0;
#pragma unroll
                    for (int bj = 0; bj < 2; ++bj) { const f32x4 v0 = acc[ai][bj][m][0] * p, v1 = acc[ai][bj][m][1] * p;
                        u32x4 w; w.x = cvt_pk_bf16(v0[0], v0[1]); w.y = cvt_pk_bf16(v0[2], v0[3]); w.z = cvt_pk_bf16(v1[0], v1[1]); w.w = cvt_pk_bf16(v1[2], v1[3]); *(u32x4*)(rp + bj * HALF) = w; } } }
    }
};
__device__ __forceinline__ unsigned pk_fp8x4(float a, float b, float c, float d) {
    a = __builtin_amdgcn_fmed3f(a, -448.f, 448.f); b = __builtin_amdgcn_fmed3f(b, -448.f, 448.f); c = __builtin_amdgcn_fmed3f(c, -448.f, 448.f); d = __builtin_amdgcn_fmed3f(d, -448.f, 448.f);
    int w = 0; w = __builtin_amdgcn_cvt_pk_fp8_f32(a, b, w, false); w = __builtin_amdgcn_cvt_pk_fp8_f32(c, d, w, true); return (unsigned)w; }
struct EpiSwiglu8 {
    static constexpr bool PERM = true, IDEMP = true, I8 = false;
    unsigned char* H; float ws_inv, hs;
    __device__ __forceinline__ void operator()(const f32x4 (&acc)[2][2][4][2], const Unit& u, int wr, int wc, int fr, int fq) const {
        const int row0 = u.pm * BM + wr * 64 + fr, col = u.pn * HALF + wc * 32 + 8 * fq;
        const float k1 = -ws_inv * LOG2E, ic = 1.0f / (ws_inv * ws_inv * hs);
#pragma unroll
        for (int ai = 0; ai < 2; ++ai)
#pragma unroll
            for (int m = 0; m < 4; ++m) { f32x4 h0, h1;
#pragma unroll
                for (int n = 0; n < 2; ++n) {
                    const f32x4 gq = acc[ai][0][m][n], uq = acc[ai][1][m][n];
                    const f32x4 tq = gq * k1, pq = gq * uq;
                    f32x4 eq; eq[0] = __builtin_amdgcn_exp2f(tq[0]); eq[1] = __builtin_amdgcn_exp2f(tq[1]); eq[2] = __builtin_amdgcn_exp2f(tq[2]); eq[3] = __builtin_amdgcn_exp2f(tq[3]);
                    const f32x4 dq = eq * ic + ic;
                    f32x4 rq; rq[0] = __builtin_amdgcn_rcpf(dq[0]); rq[1] = __builtin_amdgcn_rcpf(dq[1]); rq[2] = __builtin_amdgcn_rcpf(dq[2]); rq[3] = __builtin_amdgcn_rcpf(dq[3]);
                    const f32x4 hq = pq * rq;
                    if (n == 0) h0 = hq; else h1 = hq; }
                u32x2 w; w.x = pk_fp8x4(h0[0], h0[1], h0[2], h0[3]); w.y = pk_fp8x4(h1[0], h1[1], h1[2], h1[3]);
                *(u32x2*)(H + (size_t)(row0 + ai * HALF + m * 16) * DFF + col) = w; }
    }
};
}
namespace att {
constexpr int PITCH = 144, TILE = 64 * PITCH, BUF = 2 * TILE;
typedef short v4i16_t __attribute__((ext_vector_type(4)));
struct St { f32x4 o[4]; float m, l; };
__device__ __forceinline__ s16x4 vtr(const LAS char* p) { return __builtin_bit_cast(s16x4, __builtin_amdgcn_ds_read_tr16_b64_v4i16((LAS v4i16_t*)p)); }
__device__ __forceinline__ float fexp2(float x) { return __builtin_amdgcn_exp2f(x); }

template <int MODE>
__device__ __forceinline__ void chunk(const LAS char* kt, const LAS char* vt, const bf16x8 (&qf)[2], St& st, int lane, int pa, int pb, const LAS float* bias, const int (&bidx)[8], const bool (&bok)[8]) {
    const int mrow = lane & 15, g = lane >> 4;
    f32x4 s[2];
#pragma unroll
    for (int b = 0; b < 2; ++b) {
        const int krow = 8 * (mrow >> 2) + 4 * b + (mrow & 3);
        const LAS char* kp = kt + krow * PITCH + 16 * g;
        const bf16x8 a0 = *(const LAS bf16x8*)kp, a1 = *(const LAS bf16x8*)(kp + 64);
        f32x4 z = (f32x4){0.f, 0.f, 0.f, 0.f};
        z = __builtin_amdgcn_mfma_f32_16x16x32_bf16(a0, qf[0], z, 0, 0, 0);
        z = __builtin_amdgcn_mfma_f32_16x16x32_bf16(a1, qf[1], z, 0, 0, 0);
        s[b] = z;
    }
    float p[8]; float mx = -1e30f;
    const unsigned t0 = MODE == 2 ? (unsigned)(pa + 8 * g) : 0u, span = MODE == 2 ? (unsigned)pb : 0u;
#pragma unroll
    for (int b = 0; b < 2; ++b)
#pragma unroll
        for (int i = 0; i < 4; ++i) {
            float v = s[b][i];
            if (MODE == 1) { v += bias[bidx[4 * b + i]]; v = bok[4 * b + i] ? v : -1e30f; }
            if (MODE == 2) v = (t0 + (unsigned)(4 * b + i)) <= span ? v : -1e30f;
            p[4 * b + i] = v;
        }
    mx = fmax2(fmax2(fmax2(p[0], p[1]), fmax2(p[2], p[3])), fmax2(fmax2(p[4], p[5]), fmax2(p[6], p[7])));
    mx = xmax32(xmax16(mx));
    const float mn = fmax2(st.m, mx);
    const float alpha = fexp2(st.m - mn);
    float rs = 0.f;
#pragma unroll
    for (int k = 0; k < 8; ++k) { const float e = fexp2(p[k] - mn); p[k] = e; rs += e; }
    st.l = st.l * alpha + rs; st.m = mn;
#pragma unroll
    for (int d = 0; d < 4; ++d) st.o[d] = st.o[d] * alpha;
    u32x4 pw; pw.x = cvt_pk_bf16(p[0], p[1]); pw.y = cvt_pk_bf16(p[2], p[3]); pw.z = cvt_pk_bf16(p[4], p[5]); pw.w = cvt_pk_bf16(p[6], p[7]);
    const bf16x8 pbv = __builtin_bit_cast(bf16x8, pw);
    const LAS char* vp = vt + (8 * g + (mrow >> 2)) * PITCH + (mrow & 3) * 8;
#pragma unroll
    for (int d = 0; d < 4; ++d) {
        const s16x4 lo = vtr(vp + d * 32), hi = vtr(vp + d * 32 + 4 * PITCH);
        const bf16x8 af = (bf16x8){lo[0], lo[1], lo[2], lo[3], hi[0], hi[1], hi[2], hi[3]};
        st.o[d] = __builtin_amdgcn_mfma_f32_16x16x32_bf16(af, pbv, st.o[d], 0, 0, 0);
    }
}
template <int MODE>
__device__ __forceinline__ void chunk64(const LAS char* kt, const LAS char* vt, const bf16x8 (&qf)[2], St& st, int lane, int pa, int pb) {
    const int mrow = lane & 15, g = lane >> 4;
    f32x4 s[4];
#pragma unroll
    for (int b = 0; b < 4; ++b) {
        const int krow = 32 * (b >> 1) + 8 * (mrow >> 2) + 4 * (b & 1) + (mrow & 3);
        const LAS char* kp = kt + krow * PITCH + 16 * g;
        const bf16x8 a0 = *(const LAS bf16x8*)kp, a1 = *(const LAS bf16x8*)(kp + 64);
        f32x4 z = (f32x4){0.f, 0.f, 0.f, 0.f};
        z = __builtin_amdgcn_mfma_f32_16x16x32_bf16(a0, qf[0], z, 0, 0, 0);
        z = __builtin_amdgcn_mfma_f32_16x16x32_bf16(a1, qf[1], z, 0, 0, 0);
        s[b] = z;
    }
    float p[16];
    const unsigned t0 = MODE == 2 ? (unsigned)(pa + 8 * g) : 0u, span = MODE == 2 ? (unsigned)pb : 0u;
#pragma unroll
    for (int b = 0; b < 4; ++b)
#pragma unroll
        for (int i = 0; i < 4; ++i) {
            float v = s[b][i];
            if (MODE == 2) v = (t0 + (unsigned)(32 * (b >> 1) + 4 * (b & 1) + i)) <= span ? v : -1e30f;
            p[4 * b + i] = v;
        }
    float mx = fmax2(fmax2(fmax2(fmax2(p[0], p[1]), fmax2(p[2], p[3])), fmax2(fmax2(p[4], p[5]), fmax2(p[6], p[7]))),
                     fmax2(fmax2(fmax2(p[8], p[9]), fmax2(p[10], p[11])), fmax2(fmax2(p[12], p[13]), fmax2(p[14], p[15]))));
    mx = xmax32(xmax16(mx));
    const float mn = fmax2(st.m, mx);
    const float alpha = fexp2(st.m - mn);
    float rs0 = 0.f, rs1 = 0.f;
#pragma unroll
    for (int k = 0; k < 8; ++k) { const float e0 = fexp2(p[k] - mn), e1 = fexp2(p[8 + k] - mn); p[k] = e0; p[8 + k] = e1; rs0 += e0; rs1 += e1; }
    st.l = st.l * alpha + (rs0 + rs1); st.m = mn;
#pragma unroll
    for (int d = 0; d < 4; ++d) st.o[d] = st.o[d] * alpha;
#pragma unroll
    for (int hh = 0; hh < 2; ++hh) {
        u32x4 pw; pw.x = cvt_pk_bf16(p[8 * hh], p[8 * hh + 1]); pw.y = cvt_pk_bf16(p[8 * hh + 2], p[8 * hh + 3]); pw.z = cvt_pk_bf16(p[8 * hh + 4], p[8 * hh + 5]); pw.w = cvt_pk_bf16(p[8 * hh + 6], p[8 * hh + 7]);
        const bf16x8 pbv = __builtin_bit_cast(bf16x8, pw);
        const LAS char* vp = vt + (32 * hh + 8 * g + (mrow >> 2)) * PITCH + (mrow & 3) * 8;
#pragma unroll
        for (int d = 0; d < 4; ++d) {
            const s16x4 lo = vtr(vp + d * 32), hi = vtr(vp + d * 32 + 4 * PITCH);
            const bf16x8 af = (bf16x8){lo[0], lo[1], lo[2], lo[3], hi[0], hi[1], hi[2], hi[3]};
            st.o[d] = __builtin_amdgcn_mfma_f32_16x16x32_bf16(af, pbv, st.o[d], 0, 0, 0);
        }
    }
}
__device__ __forceinline__ void finish(St& st, bf16_t* dst  , int lane) {
    const int g = lane >> 4;
    const float lt = xadd32(xadd16(st.l));
    const float inv = 1.0f / lt;
#pragma unroll
    for (int d = 0; d < 4; ++d) { const f32x4 v = st.o[d] * inv; u32x2 w; w.x = cvt_pk_bf16(v[0], v[1]); w.y = cvt_pk_bf16(v[2], v[3]); *(u32x2*)(dst + 16 * d + 4 * g) = w; }
}

__device__ __forceinline__ void na_unit(const bf16_t* __restrict__ P, bf16_t* __restrict__ CAT, const float* __restrict__ rpb, LAS char* lds, int b, int hp, int r, int cq) {
    const int tid = opaque_tid(), lane = tid & 63, w = __builtin_amdgcn_readfirstlane(tid >> 6), half = w >> 2, jb = w & 3, ht = tid & 255, h = 2 * hp + half;
    LAS char* hb = lds + half * (2 * BUF);
    LAS float* rp = (LAS float*)(lds + 4 * BUF) + half * 512;
    const bool ctxq = r < 0;
    if (!ctxq) { const float r0 = rpb[h * 465 + ht], r1 = ht + 256 < 465 ? rpb[h * 465 + ht + 256] : 0.f; rp[ht] = r0 * LOG2E; if (ht + 256 < 465) rp[ht + 256] = r1 * LOG2E; }
    const int rowb = b * RPB, mrow = lane & 15, g = lane >> 4;
    const int m0 = ctxq ? rowb + cq * 64 + 16 * jb : rowb + CTXL + r * 64 + 16 * jb;
    bf16x8 qf[2]; { const bf16_t* qp = P + (size_t)(m0 + mrow) * DIN + C_QA + h * 64 + 8 * g; qf[0] = *(const bf16x8*)qp; qf[1] = *(const bf16x8*)(qp + 32); }
    int r0 = r - 4; r0 = r0 < 0 ? 0 : (r0 > GRH - 8 ? GRH - 8 : r0);
    const int NS = ctxq ? 4 : 12;
    int bidx[8]; bool bok[8];
    { const int qc = 16 * jb + mrow, wsc = jb == 0 ? 0 : (jb == 1 ? 8 : (jb == 2 ? 24 : 32)); int c0 = qc - 8; c0 = c0 < 0 ? 0 : (c0 > 48 ? 48 : c0);
#pragma unroll
      for (int k = 0; k < 8; ++k) { const int kc = wsc + 8 * g + k; bok[k] = (kc >= c0) && (kc < c0 + 16); int idx = kc - qc + 15; bidx[k] = idx < 0 ? 0 : (idx > 30 ? 30 : idx); } }
    u32x4 rgA[4], rgB[4];
#define NA_LOAD(rg, s) do { const int base_ = (s) < 4 ? rowb + 64 * (s) : rowb + CTXL + (r0 + (s) - 4) * 64; _Pragma("unroll") for (int i_ = 0; i_ < 4; ++i_) { const int idx_ = (ht + 256 * i_) & 511; \
        rg[i_] = *(const u32x4*)(P + (size_t)(base_ + (idx_ >> 3)) * DIN + (i_ < 2 ? C_KA : C_VA) + h * 64 + (idx_ & 7) * 8); } } while (0)
#define NA_STORE(rg, bf) do { _Pragma("unroll") for (int i_ = 0; i_ < 4; ++i_) { const int idx_ = (ht + 256 * i_) & 511; \
        *(LAS u32x4*)(hb + (bf) * BUF + (i_ < 2 ? 0 : TILE) + (idx_ >> 3) * PITCH + (idx_ & 7) * 16) = rg[i_]; } } while (0)
#define NA_STEP(s, bf) do { const LAS char* kt = hb + (bf) * BUF; const LAS char* vt = kt + TILE; \
        if ((s) < 4) { chunk64<0>(kt, vt, qf, st, lane, 0, 0); } \
        else { const int kr = r0 + (s) - 4, ws = jb == 0 ? 0 : (jb == 1 ? 8 : (jb == 2 ? 24 : 32)), dr = kr - r + 7; \
            chunk<1>(kt + ws * PITCH, vt + ws * PITCH, qf, st, lane, 0, 0, rp + dr * 31, bidx, bok); } } while (0)
    St st; st.m = -1e30f; st.l = 0.f;
#pragma unroll
    for (int d = 0; d < 4; ++d) st.o[d] = (f32x4){0.f, 0.f, 0.f, 0.f};
    NA_LOAD(rgA, 0); NA_LOAD(rgB, 1); NA_STORE(rgA, 0); NA_STORE(rgB, 1); __syncthreads();
    asm volatile("" : "+v"(qf[0]), "+v"(qf[1]));
    for (int s = 0; s < NS; s += 2) {
        const bool more = s + 2 < NS;
        if (more) { NA_LOAD(rgA, s + 2); NA_LOAD(rgB, s + 3); }
        NA_STEP(s, 0); NA_STEP(s + 1, 1);
        __syncthreads();
        if (more) { NA_STORE(rgA, 0); NA_STORE(rgB, 1); __syncthreads(); }
    }
#undef NA_STEP
#undef NA_LOAD
#undef NA_STORE
    finish(st, CAT + (size_t)(m0 + mrow) * DM + h * 64, lane);
}

__device__ __forceinline__ void swa_unit(const bf16_t* __restrict__ P, bf16_t* __restrict__ CAT, const float* __restrict__ sink, LAS char* lds, int b, int kh, int qblk, int cq) {
    const int tid = opaque_tid(), lane = tid & 63, w = __builtin_amdgcn_readfirstlane(tid >> 6), gq = w >> 1, sb = w & 1, head = kh * 4 + gq;
    const bool ctxq = qblk < 0;
    const int rowb = b * RPB, mrow = lane & 15, g = lane >> 4;
    const int m0 = ctxq ? rowb + cq * 32 + 16 * sb : rowb + CTXL + qblk * 32 + 16 * sb;
    const int qw = qblk * 32 + 16 * sb, qpos = qw + mrow;
    bf16x8 qf[2]; { const bf16_t* qp = P + (size_t)(m0 + mrow) * DIN + C_QD + head * 64 + 8 * g; qf[0] = *(const bf16x8*)qp; qf[1] = *(const bf16x8*)(qp + 32); }
    const int NS = ctxq ? 4 : 9;
    const int bidx[8] = {0, 0, 0, 0, 0, 0, 0, 0}; const bool bok[8] = {true, true, true, true, true, true, true, true};
    int klo = qpos - 128; klo = klo < 0 ? 0 : klo; int khi = qpos + 128; khi = khi > SEQ - 1 ? SEQ - 1 : khi; const int kspan = khi - klo;
    u32x4 rgA[2], rgB[2];
    const int skey = tid >> 3, sch = tid & 7;
#define SW_LOAD(rg, s) do { int row_; if ((s) < 4) row_ = rowb + 64 * (s) + skey; else { int kp_ = qblk * 32 - 128 + 64 * ((s) - 4) + skey; kp_ = kp_ < 0 ? 0 : (kp_ > SEQ - 1 ? SEQ - 1 : kp_); row_ = rowb + CTXL + kp_; } \
        const bf16_t* src_ = P + (size_t)row_ * DIN + kh * 64 + sch * 8; rg[0] = *(const u32x4*)(src_ + C_KD); rg[1] = *(const u32x4*)(src_ + C_VD); } while (0)
#define SW_STORE(rg, bf) do { LAS char* d_ = lds + (bf) * BUF + skey * PITCH + sch * 16; *(LAS u32x4*)d_ = rg[0]; *(LAS u32x4*)(d_ + TILE) = rg[1]; } while (0)
#define SW_STEP(s, bf) do { const LAS char* kt = lds + (bf) * BUF; const LAS char* vt = kt + TILE; \
        if ((s) < 4) { chunk64<0>(kt, vt, qf, st, lane, 0, 0); } \
        else { const int kpa = qblk * 32 - 128 + 64 * ((s) - 4), kpb = kpa + 32; \
            const bool skipa = (kpa > qw + 15 + 128) || (kpa + 31 < qw - 128) || (kpa + 31 < 0) || (kpa >= SEQ), skipb = (kpb > qw + 15 + 128) || (kpb + 31 < qw - 128) || (kpb + 31 < 0) || (kpb >= SEQ); \
            if (!skipa && !skipb) chunk64<2>(kt, vt, qf, st, lane, kpa - klo, kspan); \
            else { if (!skipa) chunk<2>(kt, vt, qf, st, lane, kpa - klo, kspan, nullptr, bidx, bok); \
                   if (!skipb) chunk<2>(kt + 32 * PITCH, vt + 32 * PITCH, qf, st, lane, kpb - klo, kspan, nullptr, bidx, bok); } } } while (0)
    St st; st.m = sink[head] * LOG2E; st.l = (g == 0) ? 1.f : 0.f;
#pragma unroll
    for (int d = 0; d < 4; ++d) st.o[d] = (f32x4){0.f, 0.f, 0.f, 0.f};
    SW_LOAD(rgA, 0); SW_LOAD(rgB, 1); SW_STORE(rgA, 0); SW_STORE(rgB, 1); __syncthreads();
    asm volatile("" : "+v"(qf[0]), "+v"(qf[1]));
    for (int s = 0; s < NS; s += 2) {
        const bool more = s + 2 < NS, more2 = s + 3 < NS;
        if (more) SW_LOAD(rgA, s + 2);
        if (more2) SW_LOAD(rgB, s + 3);
        SW_STEP(s, 0);
        if (s + 1 < NS) SW_STEP(s + 1, 1);
        __syncthreads();
        if (more) { SW_STORE(rgA, 0); if (more2) SW_STORE(rgB, 1); __syncthreads(); }
    }
#undef SW_STEP
#undef SW_LOAD
#undef SW_STORE
    finish(st, CAT + (size_t)(m0 + mrow) * DM + 1536 + head * 64, lane);
}

__device__ __forceinline__ void unpack8(const u32x4 w, float (&f)[8]) { f[0] = bflo(w.x); f[1] = bfhi(w.x); f[2] = bflo(w.y); f[3] = bfhi(w.y); f[4] = bflo(w.z); f[5] = bfhi(w.z); f[6] = bflo(w.w); f[7] = bfhi(w.w); }
template <int GI>
__device__ __forceinline__ void pc_wave(const bf16_t* __restrict__ P, bf16_t* __restrict__ CAT, const float* __restrict__ convw, int m0, int chunk) {
    constexpr int HW = 1 << GI;
    const int ch0 = GI * 128 + chunk * 8;
    const int b = m0 / RPB, r = m0 - b * RPB; const bool isctx = r < CTXL;
    const int t0 = isctx ? r : r - CTXL, n = isctx ? CTXL : SEQ;
    const bf16_t* row0 = P + (size_t)m0 * DIN;
    float w0[8], w1[8], w2[8];
#pragma unroll
    for (int k = 0; k < 8; ++k) { w0[k] = convw[ch0 + k]; w1[k] = convw[512 + ch0 + k]; w2[k] = convw[1024 + ch0 + k]; }
    float up[8], uc[8], S[8], a[8], c[8];
#pragma unroll
    for (int q = 0; q < 8; ++q) { up[q] = 0.f; S[q] = 0.f; }
    if (t0 > 0) { unpack8(*(const u32x4*)(row0 - DIN + C_GC + ch0), a); unpack8(*(const u32x4*)(row0 - DIN + C_XV + ch0), c);
#pragma unroll
        for (int q = 0; q < 8; ++q) up[q] = a[q] * c[q]; }
    { unpack8(*(const u32x4*)(row0 + C_GC + ch0), a); unpack8(*(const u32x4*)(row0 + C_XV + ch0), c);
#pragma unroll
      for (int q = 0; q < 8; ++q) uc[q] = a[q] * c[q]; }
#pragma unroll
    for (int d = -HW; d < HW; ++d) { const int j = t0 + d; if (j >= 0 && j < n) { unpack8(*(const u32x4*)(row0 + (ptrdiff_t)d * DIN + C_UB + ch0), a);
#pragma unroll
        for (int q = 0; q < 8; ++q) S[q] += a[q]; } }
    for (int k = 0; k < 8; ++k) {
        const int t = t0 + k; const bf16_t* row = row0 + (size_t)k * DIN;
        const bool hn = t + 1 < n, hp = t + HW < n, hm = t - HW >= 0;
        float un[8], gbv[8], ubt[8], ua[8], us[8];
        const u32x4 z = (u32x4){0u, 0u, 0u, 0u};
        const u32x4 l0 = hn ? *(const u32x4*)(row + DIN + C_GC + ch0) : z, l1 = hn ? *(const u32x4*)(row + DIN + C_XV + ch0) : z, l2 = *(const u32x4*)(row + C_GB + ch0),
                    l3 = *(const u32x4*)(row + C_UB + ch0), l4 = hp ? *(const u32x4*)(row + (ptrdiff_t)HW * DIN + C_UB + ch0) : z, l5 = hm ? *(const u32x4*)(row - (ptrdiff_t)HW * DIN + C_UB + ch0) : z;
        unpack8(l0, a); unpack8(l1, c);
#pragma unroll
        for (int q = 0; q < 8; ++q) un[q] = a[q] * c[q];
        unpack8(l2, gbv); unpack8(l3, ubt); unpack8(l4, ua); unpack8(l5, us);
        float y[8];
#pragma unroll
        for (int q = 0; q < 8; ++q) y[q] = gbv[q] * (w0[q] * up[q] + w1[q] * uc[q] + w2[q] * un[q]);
        u32x4 oc; oc.x = pk2(y[0], y[1]); oc.y = pk2(y[2], y[3]); oc.z = pk2(y[4], y[5]); oc.w = pk2(y[6], y[7]);
        const int m = m0 + k;
        *(u32x4*)(CAT + (size_t)m * DM + 1024 + ch0) = oc;
        int lo = t - HW; lo = lo < 0 ? 0 : lo; int hi = t + HW; hi = hi > n ? n : hi;
        const float ic = 1.0f / (float)(hi - lo);
        u32x4 ob; ob.x = pk2(S[0] * ic - ubt[0], S[1] * ic - ubt[1]); ob.y = pk2(S[2] * ic - ubt[2], S[3] * ic - ubt[3]); ob.z = pk2(S[4] * ic - ubt[4], S[5] * ic - ubt[5]); ob.w = pk2(S[6] * ic - ubt[6], S[7] * ic - ubt[7]);
        *(u32x4*)(CAT + (size_t)m * DM + 512 + ch0) = ob;
#pragma unroll
        for (int q = 0; q < 8; ++q) { S[q] += ua[q] - us[q]; up[q] = uc[q]; uc[q] = un[q]; }
    }
}
__device__ __forceinline__ void pc_unit(const bf16_t* __restrict__ P, bf16_t* __restrict__ CAT, const float* __restrict__ convw, int unit) {
    const int tid = opaque_tid(), lane = tid & 63, w = __builtin_amdgcn_readfirstlane(tid >> 6), gi = w & 3;
    const int m0 = unit * 64 + (w >> 2) * 32 + (lane >> 4) * 8, chunk = lane & 15;
    if (gi == 0) pc_wave<0>(P, CAT, convw, m0, chunk); else if (gi == 1) pc_wave<1>(P, CAT, convw, m0, chunk); else if (gi == 2) pc_wave<2>(P, CAT, convw, m0, chunk); else pc_wave<3>(P, CAT, convw, m0, chunk);
}
}
#define XB_TMO      128
#define XB_XCNT(j)  (256  + 64 * (j))
#define XB_XSUB(j)  (1280 + 64 * (j))
#define XB_XGEN(j)  (2304 + 64 * (j))
#define XB_TOP      3328
#define XB_TOPGEN   3392
#define XCD_BAR_WORDS 3456
#define XB_SPIN_CAP (1u << 18)

__device__ __forceinline__ unsigned xb_ld(unsigned* p)              { return __hip_atomic_load(p, __ATOMIC_RELAXED, __HIP_MEMORY_SCOPE_AGENT); }
__device__ __forceinline__ unsigned xb_add(unsigned* p, unsigned v) { return __hip_atomic_fetch_add(p, v, __ATOMIC_RELAXED, __HIP_MEMORY_SCOPE_AGENT); }
__device__ __forceinline__ unsigned xb_xcc_id() { return (unsigned)__builtin_amdgcn_s_getreg((3 << 11) | 20) & 0xFu; }
#define XB_SPIN(cond, bar) do { unsigned _sp = 0; while (cond) { __builtin_amdgcn_s_sleep(1); \
    if ((++_sp & 255u) == 0u) { if (xb_ld(&(bar)[XB_TMO])) break; if (_sp > XB_SPIN_CAP) { atomicAdd(&(bar)[XB_TMO], 1u); break; } } } } while (0)

struct XcdBarrier {
    unsigned* bar; unsigned x;
    volatile LAS unsigned* st;
};

__device__ __forceinline__ XcdBarrier xcd_barrier_post(unsigned* bar, volatile LAS unsigned* st) {
    XcdBarrier b; b.bar = bar; b.x = xb_xcc_id(); b.st = st;
    if (threadIdx.x == 0) (void)xb_add(&bar[XB_XCNT(b.x)], 1u);
    return b;
}
__device__ __forceinline__ void xcd_barrier_complete(unsigned* bar, unsigned x, unsigned& nloc, unsigned& nx) {
    const unsigned G = gridDim.x * gridDim.y * gridDim.z;
    unsigned sum, cnt, mine, sp = 0u;
    for (;;) {
        sum = 0u; cnt = 0u; mine = 0u;
#pragma unroll
        for (unsigned j = 0; j < 16; ++j) { const unsigned c = xb_ld(&bar[XB_XCNT(j)]); sum += c; cnt += (c > 0u) ? 1u : 0u; mine = (j == x) ? c : mine; }
        if (sum == G) break;
        __builtin_amdgcn_s_sleep(1);
        if ((++sp & 255u) == 0u) { if (xb_ld(&bar[XB_TMO])) break; if (sp > XB_SPIN_CAP) { atomicAdd(&bar[XB_TMO], 1u); break; } }
    }
    nloc = mine > 0u ? mine : 1u; nx = cnt > 0u ? cnt : 1u;
}

__device__ __forceinline__ void xcd_barrier(const XcdBarrier& b) {
    asm volatile("s_waitcnt vmcnt(0)" ::: "memory");
    __syncthreads();
    if (threadIdx.x == 0) {
        unsigned* bar = b.bar;
        __builtin_amdgcn_s_waitcnt(0);
        unsigned nloc = b.st[0], nx = b.st[1];
        if (nloc == 0u) { xcd_barrier_complete(bar, b.x, nloc, nx); b.st[0] = nloc; b.st[1] = nx; }
        const unsigned old = xb_add(&bar[XB_XSUB(b.x)], 1u);
        const unsigned gen = old / nloc;
        if (old + 1u == (gen + 1u) * nloc) {
            __builtin_amdgcn_fence(__ATOMIC_RELEASE, "agent");
            asm volatile("s_waitcnt vmcnt(0)" ::: "memory");
            const unsigned og = xb_add(&bar[XB_TOP], 1u);
            const unsigned tg = og / nx;
            if (og + 1u == (tg + 1u) * nx) xb_add(&bar[XB_TOPGEN], 1u);
            else XB_SPIN(xb_ld(&bar[XB_TOPGEN]) == tg, bar);
            __builtin_amdgcn_fence(__ATOMIC_ACQUIRE, "agent");
            xb_add(&bar[XB_XGEN(b.x)], 1u);
            asm volatile("s_waitcnt vmcnt(0)" ::: "memory");
        } else {
            XB_SPIN(xb_ld(&bar[XB_XGEN(b.x)]) == gen, bar);
            __builtin_amdgcn_fence(__ATOMIC_ACQUIRE, "agent");
            asm volatile("s_waitcnt vmcnt(0)" ::: "memory");
        }
    }
    __syncthreads();
}
constexpr int RING_BYTES = 131072;
constexpr int MISC_OFF = RING_BYTES + 320;
constexpr int LDS_BYTES = 147456;
constexpr int NWAVES = 8;

struct Args { const float* in[23]; float* out; unsigned char* ws; int ph_lo, ph_hi; };
enum { I_X = 0, I_C, I_CTX, I_CCTX, I_WADA, I_BADA, I_NMIX, I_NFFN, I_NFIN, I_WIN, I_WOUT, I_RPB, I_POOLW, I_POOLS, I_CONVW, I_SINK, I_FG, I_FU, I_FD, I_ROUTER, I_MG, I_MU, I_MD };

template <bool BLK = false>
__device__ __forceinline__ void tr_item(const float* __restrict__ W, int ldw, int scol, int k0, bf16_t* __restrict__ WT, int ldk, int n0, LAS float* scr, int lane) {
    const float* src = W + (size_t)(k0 + (lane >> 5)) * ldw + scol;
    float tv[32];
#pragma unroll
    for (int i = 0; i < 32; ++i) tv[i] = __builtin_nontemporal_load(src + (size_t)(2 * i) * ldw);
#pragma unroll
    for (int i = 0; i < 32; ++i) { const int kk = 2 * i + (lane >> 5); scr[kk * 33 + (lane & 31)] = tv[i]; }
    asm volatile("s_waitcnt lgkmcnt(0)" ::: "memory");
    const int c = lane & 7;
#pragma unroll
    for (int j = 0; j < 4; ++j) { const int n = (lane >> 3) + 8 * j; const LAS float* s = scr + (8 * c) * 33 + n;
        u32x4 o; o.x = pk2(s[0 * 33], s[1 * 33]); o.y = pk2(s[2 * 33], s[3 * 33]); o.z = pk2(s[4 * 33], s[5 * 33]); o.w = pk2(s[6 * 33], s[7 * 33]);
        if (BLK) { const int nn = n0 + n; *(u32x4*)(WT + (size_t)(nn >> 8) * (256 * (size_t)ldk) + (size_t)(k0 >> 6) * (256 * 64) + (nn & 255) * 64 + 8 * c) = o; }
        else *(u32x4*)(WT + (size_t)(n0 + n) * ldk + k0 + 8 * c) = o; }
    asm volatile("s_waitcnt lgkmcnt(0)" ::: "memory");
}

__device__ __forceinline__ void tr_item8(const float* __restrict__ W, int ldw, int scol, int k0, unsigned char* __restrict__ WT, int ldk, int n0, float sc, LAS float* scr, int lane) {
    const float* src = W + (size_t)(k0 + (lane >> 5)) * ldw + scol;
    float tv[32];
#pragma unroll
    for (int i = 0; i < 32; ++i) tv[i] = __builtin_nontemporal_load(src + (size_t)(2 * i) * ldw);
#pragma unroll
    for (int i = 0; i < 32; ++i) { const int kk = 2 * i + (lane >> 5); scr[kk * 33 + (lane & 31)] = tv[i]; }
    asm volatile("s_waitcnt lgkmcnt(0)" ::: "memory");
    const int n = lane >> 1, hf = lane & 1; const LAS float* s = scr + (32 * hf) * 33 + n;
    u32x4 o0, o1;
    o0.x = pg8::pk_fp8x4(s[0 * 33] * sc, s[1 * 33] * sc, s[2 * 33] * sc, s[3 * 33] * sc); o0.y = pg8::pk_fp8x4(s[4 * 33] * sc, s[5 * 33] * sc, s[6 * 33] * sc, s[7 * 33] * sc);
    o0.z = pg8::pk_fp8x4(s[8 * 33] * sc, s[9 * 33] * sc, s[10 * 33] * sc, s[11 * 33] * sc); o0.w = pg8::pk_fp8x4(s[12 * 33] * sc, s[13 * 33] * sc, s[14 * 33] * sc, s[15 * 33] * sc);
    o1.x = pg8::pk_fp8x4(s[16 * 33] * sc, s[17 * 33] * sc, s[18 * 33] * sc, s[19 * 33] * sc); o1.y = pg8::pk_fp8x4(s[20 * 33] * sc, s[21 * 33] * sc, s[22 * 33] * sc, s[23 * 33] * sc);
    o1.z = pg8::pk_fp8x4(s[24 * 33] * sc, s[25 * 33] * sc, s[26 * 33] * sc, s[27 * 33] * sc); o1.w = pg8::pk_fp8x4(s[28 * 33] * sc, s[29 * 33] * sc, s[30 * 33] * sc, s[31 * 33] * sc);
    unsigned char* dst = WT + (size_t)(n0 + n) * ldk + k0 + 32 * hf;
    *(u32x4*)dst = o0; *(u32x4*)(dst + 16) = o1;
    asm volatile("s_waitcnt lgkmcnt(0)" ::: "memory");
}

__device__ __forceinline__ unsigned pk_i8x4(float a, float b, float c, float d) {
    const int ia = (int)__builtin_rintf(a), ib = (int)__builtin_rintf(b), ic = (int)__builtin_rintf(c), id = (int)__builtin_rintf(d);
    return (unsigned)(ia & 255) | ((unsigned)(ib & 255) << 8) | ((unsigned)(ic & 255) << 16) | ((unsigned)(id & 255) << 24); }
__device__ __forceinline__ void tr_item_i8(const float* __restrict__ W, int ldw, int scol, int k0, unsigned char* __restrict__ WT, int ldk, int n0, const unsigned* __restrict__ colmax, LAS float* scr, int lane) {
    const float* src = W + (size_t)(k0 + (lane >> 5)) * ldw + scol;
    float tv[32];
#pragma unroll
    for (int i = 0; i < 32; ++i) tv[i] = __builtin_nontemporal_load(src + (size_t)(2 * i) * ldw);
#pragma unroll
    for (int i = 0; i < 32; ++i) { const int kk = 2 * i + (lane >> 5); scr[kk * 33 + (lane & 31)] = tv[i]; }
    asm volatile("s_waitcnt lgkmcnt(0)" ::: "memory");
    const int n = lane >> 1, hf = lane & 1; const LAS float* s = scr + (32 * hf) * 33 + n;
    const float cm = __uint_as_float(colmax[n0 + n]); const float sc = cm > 0.f ? 127.0f / cm : 0.f;
    u32x4 o0, o1;
    o0.x = pk_i8x4(s[0 * 33] * sc, s[1 * 33] * sc, s[2 * 33] * sc, s[3 * 33] * sc); o0.y = pk_i8x4(s[4 * 33] * sc, s[5 * 33] * sc, s[6 * 33] * sc, s[7 * 33] * sc);
    o0.z = pk_i8x4(s[8 * 33] * sc, s[9 * 33] * sc, s[10 * 33] * sc, s[11 * 33] * sc); o0.w = pk_i8x4(s[12 * 33] * sc, s[13 * 33] * sc, s[14 * 33] * sc, s[15 * 33] * sc);
    o1.x = pk_i8x4(s[16 * 33] * sc, s[17 * 33] * sc, s[18 * 33] * sc, s[19 * 33] * sc); o1.y = pk_i8x4(s[20 * 33] * sc, s[21 * 33] * sc, s[22 * 33] * sc, s[23 * 33] * sc);
    o1.z = pk_i8x4(s[24 * 33] * sc, s[25 * 33] * sc, s[26 * 33] * sc, s[27 * 33] * sc); o1.w = pk_i8x4(s[28 * 33] * sc, s[29 * 33] * sc, s[30 * 33] * sc, s[31 * 33] * sc);
    unsigned char* dst = WT + (size_t)(n0 + n) * ldk + k0 + 32 * hf;
    *(u32x4*)dst = o0; *(u32x4*)(dst + 16) = o1;
    asm volatile("s_waitcnt lgkmcnt(0)" ::: "memory");
}
__device__ __forceinline__ void quant_dense_up(const Args& a, LAS unsigned char* lds, int G) {
    const int tid = opaque_tid(), lane = tid & 63, wave = __builtin_amdgcn_readfirstlane(tid >> 6), j = lane & 31;
    unsigned char* ws = a.ws; const unsigned* colmax = (const unsigned*)(ws + WS_CTL) + CW_COLMAX;
    LAS float* scr = (LAS float*)(lds + wave * 8448);
    const int gw = blockIdx.x * NWAVES + wave, NGW = G * NWAVES;
    for (int r = gw; r < 32 * 448; r += NGW) { const int kb = r / 448, nb = r % 448, n0 = nb * 32, tile = n0 >> 8, o = n0 & 255; const bool isup = o >= 128;
        tr_item_i8(isup ? a.in[I_FU] : a.in[I_FG], DFF, tile * 128 + (o & 127) + j, kb * 64, ws + WS_WGU, DM, n0, colmax, scr, lane); }
    float* colsc = (float*)(ws + WS_COLSC);
    for (int i = blockIdx.x * 512 + tid; i < NGU; i += G * 512) colsc[i] = __uint_as_float(colmax[i]) * (1.0f / 127.0f);
}

__device__ __forceinline__ void quant_w_in(const Args& a, LAS unsigned char* lds, int G, int l) {
    const int tid = opaque_tid(), lane = tid & 63, wave = __builtin_amdgcn_readfirstlane(tid >> 6), j = lane & 31;
    unsigned char* ws = a.ws; const unsigned* colmax = (const unsigned*)(ws + WS_CTL) + CW_COLMAX_IN + l * DIN;
    LAS float* scr = (LAS float*)(lds + wave * 8448);
    const int gw = blockIdx.x * NWAVES + wave, NGW = G * NWAVES;
    for (int r = gw; r < 32 * 136; r += NGW) { const int kb = r / 136, nb = r % 136, n0 = nb * 32; int col = n0 + j;
        if (n0 >= C_QD && n0 < C_VD) { const int hbn = col & ~63, o = col & 63, aa = o >> 3, i = o & 7; col = hbn + (i < 4 ? 4 * aa + i : 32 + 4 * aa + (i - 4)); }
        tr_item_i8(a.in[I_WIN] + (size_t)l * DM * DIN, DIN, col, kb * 64, ws + WS_WIN + (size_t)l * SZ_WIN, DM, n0, colmax, scr, lane); }
    float* colsc = (float*)(ws + WS_COLSC_IN) + l * DIN;
    for (int i = blockIdx.x * 512 + tid; i < DIN; i += G * 512) colsc[i] = __uint_as_float(colmax[i]) * (1.0f / 127.0f);
}

__constant__ double ROPE_C1[16] = {0.54030230586813977, 0.84600911028170789, 0.95041528025518285, 0.98423023447009461, 0.99500416527802582, 0.99841927779266448, 0.99950004166527784, 0.99984189028361437, 0.99995000041666526, 0.9999841886533658, 0.99999500000416663, 0.99999841886158658, 0.99999950000004167, 0.99999984188612112, 0.99999995000000041, 0.99999998418861169};
__constant__ double ROPE_S1[16] = {0.8414709848078965, 0.53316843991402285, 0.31098359290718575, 0.17689218624615005, 0.099833416646828155, 0.056204499214692491, 0.031617506402433708, 0.01778185687966613, 0.0099998333341666645, 0.0056233836139601857, 0.0031622723897082477, 0.0017782784728035289, 0.00099999983333334168, 0.00056234129555235944, 0.00031622776074637522, 0.00017782794006665674};

__device__ __forceinline__ void p0_prologue(const Args& a, LAS unsigned char* lds, int G) {
    const int tid = opaque_tid(), lane = tid & 63, wave = __builtin_amdgcn_readfirstlane(tid >> 6);
    unsigned char* ws = a.ws;
    {
        LAS float* sv = (LAS float*)lds; LAS float* red = (LAS float*)(lds + 24576);
        { float xs[12];
#pragma unroll
          for (int q = 0; q < 12; ++q) { const int v = q >> 2, k = (tid + 512 * q) & 2047; xs[q] = v < 2 ? a.in[I_C][v * DM + k] : a.in[I_CCTX][k]; }
#pragma unroll
          for (int q = 0; q < 12; ++q) sv[tid + 512 * q] = xs[q] / (1.0f + expf(-xs[q])); }
        __syncthreads();
        float* MOD = (float*)(ws + WS_MOD);
        for (int unit = blockIdx.x; unit < 512; unit += G) {
            const int l = unit >> 8, n0 = (unit & 255) * 48;
            if (tid < 384) {
                const int cg = tid % 12, ks = tid / 12;
                const float* wp = a.in[I_WADA] + ((size_t)l * DM + 64 * ks) * 12288 + n0 + 4 * cg;
                f32x4 acc[3]; acc[0] = acc[1] = acc[2] = (f32x4){0.f, 0.f, 0.f, 0.f};
#pragma unroll 32
                for (int kk = 0; kk < 64; ++kk) { const f32x4 w = *(const f32x4*)(wp + (size_t)kk * 12288); const int k = 64 * ks + kk;
                    acc[0] += w * sv[k]; acc[1] += w * sv[DM + k]; acc[2] += w * sv[2 * DM + k]; }
#pragma unroll
                for (int v = 0; v < 3; ++v) *(LAS f32x4*)(red + (ks * 12 + cg) * 12 + v * 4) = acc[v];
            }
            __syncthreads();
            if (tid < 144) { const int v = tid / 48, c = tid % 48, cg = c >> 2, ci = c & 3; float s = 0.f;
                for (int ks = 0; ks < 32; ++ks) s += red[(ks * 12 + cg) * 12 + v * 4 + ci];
                MOD[(size_t)(l * 3 + v) * 12288 + n0 + c] = s + a.in[I_BADA][l * 12288 + n0 + c]; }
            __syncthreads();
        }
    }
    { const int gt = blockIdx.x * 512 + tid;
      if (gt < 128 * 16) { const int pos = gt >> 4, f = gt & 15; double cr = 1.0, ci = 0.0, br = ROPE_C1[f], bi = ROPE_S1[f];
#pragma unroll
          for (int bit = 0; bit < 7; ++bit) { if ((pos >> bit) & 1) { const double t = cr * br - ci * bi; ci = cr * bi + ci * br; cr = t; } const double t2 = br * br - bi * bi; bi = 2.0 * br * bi; br = t2; }
          ((f32x2*)(ws + WS_ROPE))[gt] = (f32x2){(float)cr, (float)ci}; } }
    { LAS float* woL = (LAS float*)lds; LAS float* pwL = (LAS float*)(lds + 32768);
      for (int it = blockIdx.x; it < 256; it += G) {
        const int l = it >> 7, g = (it >> 5) & 3, nb = it & 31;
        const float* pw = a.in[I_POOLW] + (size_t)((l * 4 + g) * 128) * 128;
        const float* sc = a.in[I_POOLS] + l * 512 + g * 128;
        const float* wo = a.in[I_WOUT] + ((size_t)l * DM + 512 + g * 128) * DM + nb * 64;
        f32x4 wv[4], pv[8]; float sv[4];
#pragma unroll
        for (int i = 0; i < 4; ++i) { const int idx = tid + 512 * i; wv[i] = *(const f32x4*)(wo + (size_t)(idx >> 4) * DM + 4 * (idx & 15)); sv[i] = sc[idx >> 4]; }
#pragma unroll
        for (int i = 0; i < 8; ++i) pv[i] = *(const f32x4*)(pw + 4 * (tid + 512 * i));
#pragma unroll
        for (int i = 0; i < 4; ++i) *(LAS f32x4*)(woL + 4 * (tid + 512 * i)) = wv[i] * sv[i];
#pragma unroll
        for (int i = 0; i < 8; ++i) *(LAS f32x4*)(pwL + 4 * (tid + 512 * i)) = pv[i];
        __syncthreads();
        float acc[16];
#pragma unroll
        for (int c = 0; c < 16; ++c) acc[c] = 0.f;
        for (int d = 0; d < 128; d += 4) {
            const float w0 = woL[d * 64 + lane], w1 = woL[(d + 1) * 64 + lane], w2 = woL[(d + 2) * 64 + lane], w3 = woL[(d + 3) * 64 + lane];
#pragma unroll
            for (int c = 0; c < 16; ++c) { const f32x4 p = *(const LAS f32x4*)(pwL + (16 * wave + c) * 128 + d); acc[c] += (p[0] * w0 + p[1] * w1) + (p[2] * w2 + p[3] * w3); }
        }
        bf16_t* dst = (bf16_t*)(ws + WS_WOUT + (size_t)l * SZ_WOUT) + (size_t)(nb * 64 + lane) * DM + 512 + g * 128 + 16 * wave;
        u32x4 o0, o1; o0.x = pk2(acc[0], acc[1]); o0.y = pk2(acc[2], acc[3]); o0.z = pk2(acc[4], acc[5]); o0.w = pk2(acc[6], acc[7]);
        o1.x = pk2(acc[8], acc[9]); o1.y = pk2(acc[10], acc[11]); o1.z = pk2(acc[12], acc[13]); o1.w = pk2(acc[14], acc[15]);
        *(u32x4*)dst = o0; *(u32x4*)(dst + 8) = o1;
        __syncthreads();
      } }
    {
        LAS float* scr = (LAS float*)(lds + wave * 8448);
        const int gw = blockIdx.x * NWAVES + wave, NGW = G * NWAVES, j = lane & 31;
        constexpr int T0 = 2 * 32 * 136, T1 = 2 * 24 * 64, T2 = 32 * 448, T3 = 112 * 64;
        for (int it = gw; it < T0 + T1 + T2 + T3; it += NGW) {
            int r = it;
            if (r < T0) { const int l = r / 4352; r -= l * 4352; const int kb = r / 136, nb = r % 136, n0 = nb * 32; int col = n0 + j;
                if (n0 >= C_QD && n0 < C_VD) { const int hbn = col & ~63, o = col & 63, aa = o >> 3, i = o & 7; col = hbn + (i < 4 ? 4 * aa + i : 32 + 4 * aa + (i - 4)); }
                { const float* src = a.in[I_WIN] + (size_t)l * DM * DIN + (size_t)(kb * 64 + (lane >> 5)) * DIN + col; float mxv = 0.f;
#pragma unroll
                  for (int i = 0; i < 32; ++i) mxv = fmaxf(mxv, fabsf(__builtin_nontemporal_load(src + (size_t)(2 * i) * DIN)));
                  mxv = fmaxf(mxv, __shfl_xor(mxv, 32));
                  if (lane < 32) atomicMax((unsigned*)(ws + WS_CTL) + CW_COLMAX_IN + l * DIN + n0 + j, __float_as_uint(mxv)); }
                continue; }
            r -= T0;
            if (r < T1) { const int l = r / 1536; r -= l * 1536; int kb = r / 64; const int nb = r % 64; kb = kb < 8 ? kb : kb + 8;
                tr_item(a.in[I_WOUT] + (size_t)l * DM * DM, DM, nb * 32 + j, kb * 64, (bf16_t*)(ws + WS_WOUT + (size_t)l * SZ_WOUT), DM, nb * 32, scr, lane); continue; }
            r -= T1;
            if (r < T2) { const int kb = r / 448, nb = r % 448, n0 = nb * 32, tile = n0 >> 8, o = n0 & 255; const bool isup = o >= 128;
                const float* src = (isup ? a.in[I_FU] : a.in[I_FG]) + (size_t)(kb * 64 + (lane >> 5)) * DFF + tile * 128 + (o & 127) + j; float mxv = 0.f;
#pragma unroll
                for (int i = 0; i < 32; ++i) mxv = fmaxf(mxv, fabsf(__builtin_nontemporal_load(src + (size_t)(2 * i) * DFF)));
                mxv = fmaxf(mxv, __shfl_xor(mxv, 32));
                if (lane < 32) atomicMax((unsigned*)(ws + WS_CTL) + CW_COLMAX + n0 + j, __float_as_uint(mxv)); continue; }
            r -= T2;
            { const int kb = r / 64, nb = r % 64; tr_item<true>(a.in[I_FD], DM, nb * 32 + j, kb * 64, (bf16_t*)(ws + WS_WD), DFF, nb * 32, scr, lane); }
        }
    }
}

constexpr int CW_Q = 8192, CW_DONE = 8256;
constexpr int QI_UP = 8 * 32 * 448, QI_DN = 8 * 112 * 64, QGRABS = (QI_UP + QI_DN) / 8;
__device__ __forceinline__ void moe_conv_fill(const Args& a, LAS unsigned char* lds, int G, int done_word) {
    const int tid = opaque_tid(), lane = tid & 63, wave = __builtin_amdgcn_readfirstlane(tid >> 6), j = lane & 31;
    unsigned char* ws = a.ws; unsigned* ctl = (unsigned*)(ws + WS_CTL);
    LAS float* scr = (LAS float*)(lds + wave * 8448); volatile LAS int* shw = (volatile LAS int*)(lds + 8 * 8448);
    if (done_word >= 0 && tid == 0) __hip_atomic_fetch_add(ctl + done_word, 1u, RLX_AGENT);
    for (;;) {
        if (tid == 0) { int g = -1; const bool stop = done_word >= 0 && __hip_atomic_load(ctl + done_word, RLX_AGENT) >= (unsigned)G;
            if (!stop) { g = (int)__hip_atomic_fetch_add(ctl + CW_Q, 1u, RLX_AGENT); if (g >= QGRABS) g = -1; } shw[0] = g; }
        __syncthreads();
        const int g = shw[0];
        __syncthreads();
        if (g < 0) break;
        int r = g * 8 + wave;
        if (r < QI_UP) { const int e = r / 14336; r -= e * 14336; const int kb = r / 448, nb = r % 448, n0 = nb * 32, tile = n0 >> 8, o = n0 & 255; const bool isup = o >= 128;
            tr_item8((isup ? a.in[I_MU] : a.in[I_MG]) + (size_t)e * DM * DFF, DFF, tile * 128 + (o & 127) + j, kb * 64, ws + WS_WGU + SZ_WGU + (size_t)e * SZ_WGU8, DM, n0, WSC_UP, scr, lane); }
        else { r -= QI_UP; const int e = r / 7168; r -= e * 7168; const int kb = r / 64, nb = r % 64;
            tr_item8(a.in[I_MD] + (size_t)e * DFF * DM, DM, nb * 32 + j, kb * 64, ws + WS_WD + SZ_WD + (size_t)e * SZ_WD8, DFF, nb * 32, WSC_DN, scr, lane); }
    }
}

template <bool ROUTE, bool OUT_I8 = false>
__device__ __forceinline__ void norm_phase(const Args& a, LAS unsigned char* lds, int G, const float* gain, const float* mod, int shc, int scc, bool from_inputs, const float* router, const unsigned short* part, const float* pgate, int nparts, bool ctx_in) {
    const int tid = opaque_tid(), lane = tid & 63, wave = __builtin_amdgcn_readfirstlane(tid >> 6);
    unsigned char* ws = a.ws;
    LAS float* GT = (LAS float*)lds; LAS float* SH = GT + 3 * DM; LAS float* RT = SH + 3 * DM;
    LAS int* ES = (LAS int*)(RT + 8 * DM);
    for (int i = tid; i < 3 * DM; i += 512) { const int v = i >> 11, c = i & 2047; GT[i] = gain[c] * (1.0f + mod[v * 12288 + scc * DM + c]); SH[i] = mod[v * 12288 + shc * DM + c]; }
    if (ROUTE) for (int i = tid; i < 8 * DM; i += 512) { const int c = i >> 3, e = i & 7; RT[e * DM + c] = router[i]; }
    __syncthreads();
    const unsigned short* X = (const unsigned short*)(ws + WS_X); bf16_t* XN = (bf16_t*)(ws + WS_XN);
    const int ngroups = ROUTE ? NTOK / 64 : MROWS / 64;
    for (int grp = blockIdx.x; grp < ngroups; grp += G) {
        auto rowm = [&](int k) -> int { if (ROUTE) { const int tk = grp * 64 + wave * 8 + k; return (tk / SEQ) * RPB + CTXL + (tk % SEQ); } return grp * 64 + wave * 8 + k; };
        auto f32row = [&](int m) -> bool { const int b = m / RPB, r = m - b * RPB; return from_inputs || (!ROUTE && part != nullptr && r < CTXL && ctx_in); };
        auto proc = [&](f32x4 (&x)[8], const int m, const int k) {
            const int b = m / RPB, r = m - b * RPB, v = r < CTXL ? 2 : b;
            const bool cpart = !ROUTE && part != nullptr && r < CTXL;
            float ss = 0.f;
            if (cpart) {
#pragma unroll
                for (int j = 0; j < 8; ++j) { f32x4 sacc = (f32x4){0.f, 0.f, 0.f, 0.f}; const unsigned short* pp = part + (size_t)(b * 256 + r) * DM + 4 * lane + 256 * j;
                    for (int sI = 0; sI < nparts; ++sI) { const u32x2 pw_ = *(const u32x2*)(pp + (size_t)sI * 512 * DM); sacc += unpk_h4(pw_.x, pw_.y); }
                    x[j] += *(const f32x4*)(pgate + 4 * lane + 256 * j) * sacc;
                    if (ctx_in) { u32x2 wv; wv.x = pkh2(x[j][0], x[j][1]); wv.y = pkh2(x[j][2], x[j][3]); *(u32x2*)((unsigned short*)(ws + WS_X) + (size_t)m * DM + 4 * lane + 256 * j) = wv; } } }
#pragma unroll
            for (int j = 0; j < 8; ++j) ss += (x[j][0] * x[j][0] + x[j][1] * x[j][1]) + (x[j][2] * x[j][2] + x[j][3] * x[j][3]);
            const float rstd = 1.0f / sqrtf(wave_sum(ss) * (1.0f / DM) + EPS);
            float lg[8];
#pragma unroll
            for (int e = 0; e < 8; ++e) lg[e] = 0.f;
            float qs = 0.f;
            if (OUT_I8) {
                float am = 0.f;
#pragma unroll
                for (int j = 0; j < 8; ++j) { const int c = 4 * lane + 256 * j; const f32x4 gv = *(const LAS f32x4*)(GT + v * DM + c), sh = *(const LAS f32x4*)(SH + v * DM + c);
                    const f32x4 h = x[j] * rstd * gv + sh; am = fmaxf(am, fmaxf(fmaxf(fabsf(h[0]), fabsf(h[1])), fmaxf(fabsf(h[2]), fabsf(h[3])))); }
#pragma unroll
                for (int o = 1; o < 64; o <<= 1) am = fmaxf(am, __shfl_xor(am, o));
                qs = am > 0.f ? 127.0f / am : 0.f;
                if (lane == 0) ((float*)(ws + WS_ROWSC))[m] = am * (1.0f / 127.0f);
            }
#pragma unroll
            for (int j = 0; j < 8; ++j) { const int c = 4 * lane + 256 * j; const f32x4 gv = *(const LAS f32x4*)(GT + v * DM + c), sh = *(const LAS f32x4*)(SH + v * DM + c);
                const f32x4 h = x[j] * rstd * gv + sh;
                if (OUT_I8) { *(unsigned*)((unsigned char*)XN + (size_t)m * DM + c) = pk_i8x4(h[0] * qs, h[1] * qs, h[2] * qs, h[3] * qs); }
                else if (ROUTE) { *(unsigned*)((unsigned char*)XN + (size_t)m * DM + c) = pg8::pk_fp8x4(h[0], h[1], h[2], h[3]); }
                else { u32x2 w; w.x = pk2(h[0], h[1]); w.y = pk2(h[2], h[3]); *(u32x2*)(XN + (size_t)m * DM + c) = w; }
                if (ROUTE) {
#pragma unroll
                    for (int e = 0; e < 8; ++e) { const f32x4 rv = *(const LAS f32x4*)(RT + e * DM + c); lg[e] += (h[0] * rv[0] + h[1] * rv[1]) + (h[2] * rv[2] + h[3] * rv[3]); } } }
            if (ROUTE) {
#pragma unroll
                for (int e = 0; e < 8; ++e) lg[e] = wave_sum(lg[e]);
                int e0 = 0; float v0 = lg[0];
#pragma unroll
                for (int e = 1; e < 8; ++e) if (lg[e] > v0) { v0 = lg[e]; e0 = e; }
                int e1 = -1; float v1 = -3.0e38f;
#pragma unroll
                for (int e = 0; e < 8; ++e) if (e != e0 && lg[e] > v1) { v1 = lg[e]; e1 = e; }
                const float p1 = 1.0f / (1.0f + expf(v0 - v1)), p0 = 1.0f - p1;
                if (lane == 0) { const int tk = grp * 64 + wave * 8 + k; ES[(wave * 8 + k) * 2] = e0; ES[(wave * 8 + k) * 2 + 1] = e1;
                    ((f32x2*)(ws + WS_ROUTE + 262144))[tk] = (f32x2){p0, p1}; }
            }
                };
        if (from_inputs) {
            for (int k = 0; k < 8; ++k) { const int m = rowm(k); const float* src = in_row(a.in[I_X], a.in[I_CTX], m); f32x4 x[8];
#pragma unroll
                for (int j = 0; j < 8; ++j) x[j] = *(const f32x4*)(src + 4 * lane + 256 * j);
                proc(x, m, k); }
        } else {
            for (int k = 0; k < 8; k += 2) { const int m0 = rowm(k), m1 = rowm(k + 1); const bool q0 = f32row(m0), q1 = f32row(m1);
                f32x4 x0[8], x1[8]; u32x2 w0[8], w1[8];
                if (q0) { const float* src = in_row(a.in[I_X], a.in[I_CTX], m0);
#pragma unroll
                    for (int j = 0; j < 8; ++j) x0[j] = *(const f32x4*)(src + 4 * lane + 256 * j); }
                else { const unsigned short* src = X + (size_t)m0 * DM;
#pragma unroll
                    for (int j = 0; j < 8; ++j) w0[j] = *(const u32x2*)(src + 4 * lane + 256 * j); }
                if (q1) { const float* src = in_row(a.in[I_X], a.in[I_CTX], m1);
#pragma unroll
                    for (int j = 0; j < 8; ++j) x1[j] = *(const f32x4*)(src + 4 * lane + 256 * j); }
                else { const unsigned short* src = X + (size_t)m1 * DM;
#pragma unroll
                    for (int j = 0; j < 8; ++j) w1[j] = *(const u32x2*)(src + 4 * lane + 256 * j); }
                if (!q0) {
#pragma unroll
                    for (int j = 0; j < 8; ++j) x0[j] = unpk_h4(w0[j].x, w0[j].y); }
                proc(x0, m0, k);
                if (!q1) {
#pragma unroll
                    for (int j = 0; j < 8; ++j) x1[j] = unpk_h4(w1[j].x, w1[j].y); }
                proc(x1, m1, k + 1); }
        }
        if (ROUTE) {
            __syncthreads();
            if (wave == 0) { const int e0 = ES[lane * 2], e1 = ES[lane * 2 + 1]; int lr0 = 0, lr1 = 0; int mycnt = 0;
#pragma unroll
                for (int e = 0; e < 8; ++e) { const unsigned long long mk = __ballot(e0 == e || e1 == e); const int below = __popcll(mk & ((1ull << lane) - 1ull));
                    if (e0 == e) lr0 = below; if (e1 == e) lr1 = below; if (lane == e) mycnt = __popcll(mk); }
                ((int4*)(ws + WS_ROUTE))[grp * 64 + lane] = make_int4(e0, e1, lr0, lr1);
                if (lane < 8) ((int*)(ws + WS_CNT))[grp * 8 + lane] = mycnt; }
            __syncthreads();
        }
    }
}

__device__ __forceinline__ void slot_phase(const Args& a, LAS unsigned char* lds, int G) {
    const int tid = opaque_tid(), lane = tid & 63;
    unsigned char* ws = a.ws;
    LAS int* C = (LAS int*)lds; LAS int* TOT = C + 2048; LAS int* BASE = TOT + 8; LAS int* P = BASE + 8;
    const int* CNT = (const int*)(ws + WS_CNT);
    for (int i = tid; i < 2048; i += 512) C[i] = CNT[i];
    __syncthreads();
    { const int e = __builtin_amdgcn_readfirstlane(tid >> 6);
      const int v0 = C[(4 * lane) * 8 + e], v1 = C[(4 * lane + 1) * 8 + e], v2 = C[(4 * lane + 2) * 8 + e], v3 = C[(4 * lane + 3) * 8 + e];
      const int s = (v0 + v1) + (v2 + v3); int sc = s;
#pragma unroll
      for (int o = 1; o < 64; o <<= 1) { const int t = __shfl_up(sc, o); if (lane >= o) sc += t; }
      const int ex = sc - s;
      P[(4 * lane) * 8 + e] = ex; P[(4 * lane + 1) * 8 + e] = ex + v0; P[(4 * lane + 2) * 8 + e] = ex + v0 + v1; P[(4 * lane + 3) * 8 + e] = ex + v0 + v1 + v2;
      if (lane == 63) TOT[e] = sc; }
    __syncthreads();
    if (tid == 0) { int ts = 0; for (int e = 0; e < 8; ++e) { BASE[e] = ts * 256; if (blockIdx.x == 0) ((int*)(ws + WS_TILES))[1 + e] = ts; ts += (TOT[e] + 255) >> 8; } if (blockIdx.x == 0) ((int*)(ws + WS_TILES))[0] = ts; }
    __syncthreads();
    int* ROWTOK = (int*)(ws + WS_ROWTOK); int* ROWDST = (int*)(ws + WS_ROWDST); float* ROWP = (float*)(ws + WS_ROWP);
    for (int grp = blockIdx.x; grp < NTOK / 64; grp += G) {
        if (tid < 64) { const int tk = grp * 64 + lane; const int4 rt = ((const int4*)(ws + WS_ROUTE))[tk]; const f32x2 pp = ((const f32x2*)(ws + WS_ROUTE + 262144))[tk];
            const int m = (tk / SEQ) * RPB + CTXL + (tk % SEQ);
            const int s0 = BASE[rt.x] + P[grp * 8 + rt.x] + rt.z, s1 = BASE[rt.y] + P[grp * 8 + rt.y] + rt.w;
            ROWTOK[s0] = m; ROWDST[s0] = 2 * tk; ROWP[s0] = pp[0];
            ROWTOK[s1] = m; ROWDST[s1] = 2 * tk + 1; ROWP[s1] = pp[1];
            ((int*)(ws + WS_TAILF))[tk] = (s0 >= 128 * 256 || s1 >= 128 * 256) ? 1 : 0; ((int*)(ws + WS_SLOTS))[2 * tk] = s0; ((int*)(ws + WS_SLOTS))[2 * tk + 1] = s1; }
    }
    { const int e = blockIdx.x & 7; const int lo = BASE[e] + TOT[e], hi = BASE[e] + (((TOT[e] + 255) >> 8) << 8);
      for (int s = lo + (blockIdx.x >> 3) * 512 + tid; s < hi; s += ((G + 7) >> 3) * 512) { ROWTOK[s] = CTXL; ROWDST[s] = -1; ROWP[s] = 0.f; } }
}

__device__ __forceinline__ void final_phase(const Args& a, int nwg, int wgi, int tailmode) {
    const int tid = opaque_tid(), lane = tid & 63, wave = __builtin_amdgcn_readfirstlane(tid >> 6);
    unsigned char* ws = a.ws;
    const unsigned short* X = (const unsigned short*)(ws + WS_X); const bf16_t* FP = (const bf16_t*)(ws + WS_FP); const bf16_t* FP2 = (const bf16_t*)(ws + WS_FP2);
    const float* mod1 = (const float*)(ws + WS_MOD) + 3 * 12288;
    const float* gf = a.in[I_NFIN];
    const int* tailf = (const int*)(ws + WS_TAILF);
    const int tk0 = wgi * NWAVES + wave, tstep = nwg * NWAVES;
    for (int base = tk0; base < NTOK; base += 64 * tstep) {
      const int tkl = base + lane * tstep;
      unsigned long long todo = __ballot(tkl < NTOK && tailf[tkl] == tailmode);
      while (todo) {
        const int jb = __builtin_ctzll(todo); todo &= todo - 1;
        const int tk = base + jb * tstep;
        const int b = tk / SEQ, m = b * RPB + CTXL + (tk % SEQ);
        const float* g2 = mod1 + b * 12288 + 5 * DM;
        int sl0 = 0, sl1 = 0; if (tailmode) { sl0 = ((const int*)(ws + WS_SLOTS))[2 * tk]; sl1 = ((const int*)(ws + WS_SLOTS))[2 * tk + 1]; }
        f32x4 x[8]; float ss = 0.f;
#pragma unroll
        for (int j = 0; j < 8; ++j) { const int c = 4 * lane + 256 * j; const u32x2 xw = *(const u32x2*)(X + (size_t)m * DM + c); const f32x4 xv = unpk_h4(xw.x, xw.y), gv = *(const f32x4*)(g2 + c);
            const u32x2 f0 = *(const u32x2*)(FP + (size_t)(2 * tk) * DM + c), f1 = *(const u32x2*)(FP + (size_t)(2 * tk + 1) * DM + c);
            f32x4 f; f[0] = bflo(f0.x) + bflo(f1.x); f[1] = bfhi(f0.x) + bfhi(f1.x); f[2] = bflo(f0.y) + bflo(f1.y); f[3] = bfhi(f0.y) + bfhi(f1.y);
            if (tailmode) {
                if (sl0 >= 128 * 256) { const u32x2 g0 = *(const u32x2*)(FP2 + (size_t)(sl0 - 128 * 256) * DM + c); f[0] += bflo(g0.x); f[1] += bfhi(g0.x); f[2] += bflo(g0.y); f[3] += bfhi(g0.y); }
                if (sl1 >= 128 * 256) { const u32x2 g1 = *(const u32x2*)(FP2 + (size_t)(sl1 - 128 * 256) * DM + c); f[0] += bflo(g1.x); f[1] += bfhi(g1.x); f[2] += bflo(g1.y); f[3] += bfhi(g1.y); } }
            x[j] = xv + gv * f; ss += (x[j][0] * x[j][0] + x[j][1] * x[j][1]) + (x[j][2] * x[j][2] + x[j][3] * x[j][3]); }
        const float rstd = 1.0f / sqrtf(wave_sum(ss) * (1.0f / DM) + EPS);
#pragma unroll
        for (int j = 0; j < 8; ++j) { const int c = 4 * lane + 256 * j; const f32x4 gv = *(const f32x4*)(gf + c); *(f32x4*)(a.out + (size_t)tk * DM + c) = x[j] * rstd * gv; }
      }
    }
}
constexpr int N_PHASES = 18;
#ifndef MK_PER_PHASE
#define MK_PER_PHASE 0
#endif

__global__ void __launch_bounds__(NWAVES * 64, 2) mk_fwd(Args a) {
    extern __shared__ __attribute__((aligned(16))) unsigned char lds_raw[];
    LAS unsigned char* lds = (LAS unsigned char*)lds_raw;
    volatile LAS unsigned* MISC = (volatile LAS unsigned*)(lds + MISC_OFF);
    const int tid = threadIdx.x, G = gridDim.x;
    unsigned char* ws = a.ws;
    for (int u = tid; u < (LDS_BYTES - RING_BYTES) / 4; u += NWAVES * 64) ((LAS unsigned*)(lds + RING_BYTES))[u] = 0u;
    __syncthreads();
    const int lo = a.ph_lo, hi = a.ph_hi;
    XcdBarrier bar; bar.bar = (unsigned*)(ws + WS_CTL) + CW_BAR; bar.x = 0; bar.st = nullptr;
    if (hi - lo > 1) bar = xcd_barrier_post((unsigned*)(ws + WS_CTL) + CW_BAR, MISC + 8);
#define IN(k) (lo <= (k) && (k) < hi)
#define PHASE_REP(k) for (int rep_ = 0; rep_ < 1; ++rep_)
#define GRIDBAR() do { XcdBarrier b_ = bar; asm volatile("" : "+s"(b_.bar)); xcd_barrier(b_); } while (0)
#define SEAM(k) do { if ((k) + 1 < hi) { XcdBarrier b_ = bar; asm volatile("" : "+s"(b_.bar)); xcd_barrier(b_); } } while (0)
    float* MOD = (float*)(ws + WS_MOD);
    unsigned short* X = (unsigned short*)(ws + WS_X); bf16_t* XN = (bf16_t*)(ws + WS_XN); bf16_t* PROJ = (bf16_t*)(ws + WS_PROJ); bf16_t* CAT = (bf16_t*)(ws + WS_CAT);
    bf16_t* HID = (bf16_t*)(ws + WS_HID); bf16_t* FP = (bf16_t*)(ws + WS_FP);

    if (IN(0)) { PHASE_REP(0) { p0_prologue(a, lds, G); __syncthreads(); moe_conv_fill(a, lds, G, -1); } SEAM(0); }

    { constexpr int l = 0;
        const int pb = 1 + 8 * l;
        const float* modl = MOD + (size_t)l * 3 * 12288;
        if (IN(pb + 0)) { PHASE_REP(pb + 0) { norm_phase<false, true>(a, lds, G, a.in[I_NMIX] + l * DM, modl, 0, 1, l == 0, nullptr, l == 1 ? (const unsigned short*)(ws + WS_PART) : nullptr, MOD + 2 * 12288 + 5 * DM, 14, false); __syncthreads(); quant_w_in(a, lds, G, l); } SEAM(pb + 0); }
        if (IN(pb + 1)) { PHASE_REP(pb + 1) {
            pg8::Gemm g{XN, (const bf16_t*)(ws + WS_WIN + (size_t)l * SZ_WIN), DM / 2, 0, DM / 128};
            pg8::StaticOrder S; S.init(NPAN, DIN / 256, G, (int)blockIdx.x, 0);
            pg8::EpiProjI8 E{PROJ, (const f32x2*)(ws + WS_ROPE), (const float*)(ws + WS_ROWSC), (const float*)(ws + WS_COLSC_IN) + l * DIN};
            pg8::gemm_phase<pg8::EpiProjI8, pg8::StaticOrder, false, true>(lds, g, S, E, nullptr);
            } SEAM(pb + 1);
        }
        if (IN(pb + 2)) { PHASE_REP(pb + 2) {
            const float* sink = a.in[I_SINK] + l * 8; const float* rpb = a.in[I_RPB] + (size_t)l * 8 * 465; const float* convw = a.in[I_CONVW] + l * 3 * 512;
            { const bool sw = (G == 256); const int xcd = (int)blockIdx.x & 7, w = (int)blockIdx.x >> 3;
              for (int j = 0, i = blockIdx.x; i < 1024; ++j, i += G) { const int b_ = sw ? xcd >> 2 : i >> 9, kh_ = sw ? (xcd >> 1) & 1 : (i >> 8) & 1, q_ = sw ? (xcd & 1) * 128 + j * 32 + w : i & 255;
                  att::swa_unit(PROJ, CAT, sink, (LAS char*)lds, b_, kh_, q_, 0); }
              for (int j = 0, i = blockIdx.x; i < 1024; ++j, i += G) { const int b_ = sw ? xcd >> 2 : i >> 9, hp_ = sw ? xcd & 3 : (i >> 7) & 3, r_ = sw ? j * 32 + w : i & 127;
                  att::na_unit(PROJ, CAT, rpb, (LAS char*)lds, b_, hp_, r_, 0); } }
            if (l == 0) {
                for (int i = G - 1 - (int)blockIdx.x; i < 32; i += G) att::na_unit(PROJ, CAT, rpb, (LAS char*)lds, i >> 4, (i >> 2) & 3, -1, i & 3);
                for (int i = ((G - 33 - (int)blockIdx.x) % G + G) % G; i < 32; i += G) att::swa_unit(PROJ, CAT, sink, (LAS char*)lds, i >> 4, (i >> 3) & 1, -1, i & 7);
                for (int k = 0; k * G < MROWS / 64; ++k) { const int u = k * G + (((int)blockIdx.x - 64 * k) % G + G) % G; if (u < MROWS / 64) att::pc_unit(PROJ, CAT, convw, u); }
            } else {
                for (int i = blockIdx.x; i < NTOK / 64; i += G) att::pc_unit(PROJ, CAT, convw, (i >> 7) * 132 + 4 + (i & 127));
            }
            }
            SEAM(pb + 2);
        }
        if (IN(pb + 3)) { PHASE_REP(pb + 3) {
            pg8::Gemm g{CAT, (const bf16_t*)(ws + WS_WOUT + (size_t)l * SZ_WOUT), DM, 0, DM / 64};
            pg8::StaticOrder S; S.init(NPAN - 2, DM / 256, G, (int)blockIdx.x, 1);
            pg8::EpiResid E{X, a.in[I_X], a.in[I_CTX], modl + 2 * DM, l == 0 ? 1 : 0, rep_ ? (unsigned short*)(ws + WS_END) : X};
            pg8::gemm_phase<pg8::EpiResid, pg8::StaticOrder, false, true>(lds, g, S, E, nullptr);
            if (l == 0) {
                pg8::Gemm g2{CAT, (const bf16_t*)(ws + WS_WOUT), DM, 0, 8};
                pg8::CtxSplitOrder<4> S2{G, (int)blockIdx.x, 8 * 64 * 2};
                pg8::EpiPart E2{(unsigned short*)(ws + WS_PART)};
                pg8::gemm_phase<pg8::EpiPart, pg8::CtxSplitOrder<4>, false, true>(lds, g2, S2, E2, nullptr);
            }
            } SEAM(pb + 3);
        }
        if (l == 0) {
            if (IN(pb + 4)) { PHASE_REP(pb + 4) { norm_phase<false, true>(a, lds, G, a.in[I_NFFN], modl, 3, 4, false, nullptr, (const unsigned short*)(ws + WS_PART), MOD + 2 * 12288 + 2 * DM, 4, true); __syncthreads(); quant_dense_up(a, lds, G); } SEAM(pb + 4); }
            if (IN(pb + 6)) { PHASE_REP(pb + 6) {
                pg8::Gemm g{XN, (const bf16_t*)(ws + WS_WGU), DM / 2, 0, DM / 128};
                pg8::StaticOrder S; S.init(NPAN, NGU / 256, G, (int)blockIdx.x, 0);
                pg8::EpiSwigluI8 E{HID, (const float*)(ws + WS_ROWSC), (const float*)(ws + WS_COLSC)};
                pg8::gemm_phase<pg8::EpiSwigluI8, pg8::StaticOrder, false, true>(lds, g, S, E, nullptr);

                } SEAM(pb + 6);
            }
            if (IN(pb + 7)) { PHASE_REP(pb + 7) {
                pg8::Gemm g{HID, (const bf16_t*)(ws + WS_WD), DFF, 0, DFF / 64};
                pg8::StaticOrder S; S.init(NPAN - 2, DM / 256, G, (int)blockIdx.x, 1); S.wgm = 4;
                pg8::EpiResid E{X, a.in[I_X], a.in[I_CTX], modl + 5 * DM, 0, rep_ ? (unsigned short*)(ws + WS_END) : X};
                pg8::gemm_phase<pg8::EpiResid, pg8::StaticOrder, false, true, false, true>(lds, g, S, E, nullptr);
                pg8::Gemm g2{HID, (const bf16_t*)(ws + WS_WD), DFF, 0, 8};
                pg8::CtxSplitOrder<14> S2{G, (int)blockIdx.x, 8 * 256 * 64 * 2};
                pg8::EpiPart E2{(unsigned short*)(ws + WS_PART)};
                pg8::gemm_phase<pg8::EpiPart, pg8::CtxSplitOrder<14>, false, true, false, true>(lds, g2, S2, E2, nullptr);
                } SEAM(pb + 7);
            }
        } else {
            if (IN(pb + 4)) { PHASE_REP(pb + 4) { norm_phase<true>(a, lds, G, a.in[I_NFFN] + DM, modl, 3, 4, false, a.in[I_ROUTER], nullptr, nullptr, 0, false); } SEAM(pb + 4); }
            if (IN(pb + 5)) { slot_phase(a, lds, G); SEAM(pb + 5); }
            if (IN(pb + 6)) { PHASE_REP(pb + 6) {
                const int* TL = (const int*)(ws + WS_TILES);
                pg8::Gemm g{XN, (const bf16_t*)(ws + WS_WGU + SZ_WGU), DM / 2, SZ_WGU8, DM / 128};
                pg8::StaticOrder S; S.init(TL[0], NGU / 256, G, (int)blockIdx.x, 0);
#pragma unroll
                for (int e = 0; e < 8; ++e) S.ts[e] = TL[1 + e];
                pg8::EpiSwiglu8 E{(unsigned char*)HID, 1.0f / WSC_UP, HSC};
                pg8::gemm_phase<pg8::EpiSwiglu8, pg8::StaticOrder, true, true, true>(lds, g, S, E, (const int*)(ws + WS_ROWTOK));
                } SEAM(pb + 6);
            }
            if (IN(pb + 7)) { PHASE_REP(pb + 7) {
                const int* TL = (const int*)(ws + WS_TILES);
                pg8::Gemm g{HID, (const bf16_t*)(ws + WS_WD + SZ_WD), DFF / 2, SZ_WD8, DFF / 128};
                const int nmain = TL[0] < 128 ? TL[0] : 128, ntail = (TL[0] - nmain) * (DM / 256) * 2;
                pg8::StaticOrder S; S.init(nmain, DM / 256, G, (int)blockIdx.x, 0);
#pragma unroll
                for (int e = 0; e < 8; ++e) S.ts[e] = TL[1 + e];
                pg8::EpiMoeDown E{FP, (const int*)(ws + WS_ROWDST), (const float*)(ws + WS_ROWP), 1.0f / (WSC_DN * HSC), (bf16_t*)(ws + WS_FP2)};
                pg8::gemm_phase<pg8::EpiMoeDown, pg8::StaticOrder, false, true, true>(lds, g, S, E, nullptr);
                GRIDBAR();
                if ((int)blockIdx.x < ntail) {
                    pg8::TailSplitOrder S2; S2.S.init(TL[0] - nmain, 2 * (DM / 256), ntail, (int)blockIdx.x, 0); S2.S.pm0 = nmain; S2.kob = DFF / 2;
#pragma unroll
                    for (int e = 0; e < 8; ++e) S2.S.ts[e] = TL[1 + e];
                    pg8::Gemm g2 = g; g2.nt = DFF / 128 / 2;
                    pg8::gemm_phase<pg8::EpiMoeDown, pg8::TailSplitOrder, false, true, true>(lds, g2, S2, E, nullptr);
                } else final_phase(a, G - ntail, (int)blockIdx.x - ntail, 0);
                } SEAM(pb + 7);
            }
        }
        }
    { constexpr int l = 1;
        const int pb = 1 + 8 * l;
        const float* modl = MOD + (size_t)l * 3 * 12288;
        if (IN(pb + 0)) { PHASE_REP(pb + 0) { norm_phase<false, true>(a, lds, G, a.in[I_NMIX] + l * DM, modl, 0, 1, l == 0, nullptr, l == 1 ? (const unsigned short*)(ws + WS_PART) : nullptr, MOD + 2 * 12288 + 5 * DM, 14, false); __syncthreads(); quant_w_in(a, lds, G, l); } SEAM(pb + 0); }
        if (IN(pb + 1)) { PHASE_REP(pb + 1) {
            pg8::Gemm g{XN, (const bf16_t*)(ws + WS_WIN + (size_t)l * SZ_WIN), DM / 2, 0, DM / 128};
            pg8::StaticOrder S; S.init(NPAN, DIN / 256, G, (int)blockIdx.x, 0);
            pg8::EpiProjI8 E{PROJ, (const f32x2*)(ws + WS_ROPE), (const float*)(ws + WS_ROWSC), (const float*)(ws + WS_COLSC_IN) + l * DIN};
            pg8::gemm_phase<pg8::EpiProjI8, pg8::StaticOrder, false, true>(lds, g, S, E, nullptr);
            } SEAM(pb + 1);
        }
        if (IN(pb + 2)) { PHASE_REP(pb + 2) {
            const float* sink = a.in[I_SINK] + l * 8; const float* rpb = a.in[I_RPB] + (size_t)l * 8 * 465; const float* convw = a.in[I_CONVW] + l * 3 * 512;
            { const bool sw = (G == 256); const int xcd = (int)blockIdx.x & 7, w = (int)blockIdx.x >> 3;
              for (int j = 0, i = blockIdx.x; i < 1024; ++j, i += G) { const int b_ = sw ? xcd >> 2 : i >> 9, kh_ = sw ? (xcd >> 1) & 1 : (i >> 8) & 1, q_ = sw ? (xcd & 1) * 128 + j * 32 + w : i & 255;
                  att::swa_unit(PROJ, CAT, sink, (LAS char*)lds, b_, kh_, q_, 0); }
              for (int j = 0, i = blockIdx.x; i < 1024; ++j, i += G) { const int b_ = sw ? xcd >> 2 : i >> 9, hp_ = sw ? xcd & 3 : (i >> 7) & 3, r_ = sw ? j * 32 + w : i & 127;
                  att::na_unit(PROJ, CAT, rpb, (LAS char*)lds, b_, hp_, r_, 0); } }
            if (l == 0) {
                for (int i = G - 1 - (int)blockIdx.x; i < 32; i += G) att::na_unit(PROJ, CAT, rpb, (LAS char*)lds, i >> 4, (i >> 2) & 3, -1, i & 3);
                for (int i = ((G - 33 - (int)blockIdx.x) % G + G) % G; i < 32; i += G) att::swa_unit(PROJ, CAT, sink, (LAS char*)lds, i >> 4, (i >> 3) & 1, -1, i & 7);
                for (int k = 0; k * G < MROWS / 64; ++k) { const int u = k * G + (((int)blockIdx.x - 64 * k) % G + G) % G; if (u < MROWS / 64) att::pc_unit(PROJ, CAT, convw, u); }
            } else {
                for (int i = blockIdx.x; i < NTOK / 64; i += G) att::pc_unit(PROJ, CAT, convw, (i >> 7) * 132 + 4 + (i & 127));
            }
            }
            SEAM(pb + 2);
        }
        if (IN(pb + 3)) { PHASE_REP(pb + 3) {
            pg8::Gemm g{CAT, (const bf16_t*)(ws + WS_WOUT + (size_t)l * SZ_WOUT), DM, 0, DM / 64};
            pg8::StaticOrder S; S.init(NPAN - 2, DM / 256, G, (int)blockIdx.x, 1);
            pg8::EpiResid E{X, a.in[I_X], a.in[I_CTX], modl + 2 * DM, l == 0 ? 1 : 0, rep_ ? (unsigned short*)(ws + WS_END) : X};
            pg8::gemm_phase<pg8::EpiResid, pg8::StaticOrder, false, true>(lds, g, S, E, nullptr);
            if (l == 0) {
                pg8::Gemm g2{CAT, (const bf16_t*)(ws + WS_WOUT), DM, 0, 8};
                pg8::CtxSplitOrder<4> S2{G, (int)blockIdx.x, 8 * 64 * 2};
                pg8::EpiPart E2{(unsigned short*)(ws + WS_PART)};
                pg8::gemm_phase<pg8::EpiPart, pg8::CtxSplitOrder<4>, false, true>(lds, g2, S2, E2, nullptr);
            }
            } SEAM(pb + 3);
        }
        if (l == 0) {
            if (IN(pb + 4)) { PHASE_REP(pb + 4) { norm_phase<false, true>(a, lds, G, a.in[I_NFFN], modl, 3, 4, false, nullptr, (const unsigned short*)(ws + WS_PART), MOD + 2 * 12288 + 2 * DM, 4, true); __syncthreads(); quant_dense_up(a, lds, G); } SEAM(pb + 4); }
            if (IN(pb + 6)) { PHASE_REP(pb + 6) {
                pg8::Gemm g{XN, (const bf16_t*)(ws + WS_WGU), DM / 2, 0, DM / 128};
                pg8::StaticOrder S; S.init(NPAN, NGU / 256, G, (int)blockIdx.x, 0);
                pg8::EpiSwigluI8 E{HID, (const float*)(ws + WS_ROWSC), (const float*)(ws + WS_COLSC)};
                pg8::gemm_phase<pg8::EpiSwigluI8, pg8::StaticOrder, false, true>(lds, g, S, E, nullptr);

                } SEAM(pb + 6);
            }
            if (IN(pb + 7)) { PHASE_REP(pb + 7) {
                pg8::Gemm g{HID, (const bf16_t*)(ws + WS_WD), DFF, 0, DFF / 64};
                pg8::StaticOrder S; S.init(NPAN - 2, DM / 256, G, (int)blockIdx.x, 1); S.wgm = 4;
                pg8::EpiResid E{X, a.in[I_X], a.in[I_CTX], modl + 5 * DM, 0, rep_ ? (unsigned short*)(ws + WS_END) : X};
                pg8::gemm_phase<pg8::EpiResid, pg8::StaticOrder, false, true, false, true>(lds, g, S, E, nullptr);
                pg8::Gemm g2{HID, (const bf16_t*)(ws + WS_WD), DFF, 0, 8};
                pg8::CtxSplitOrder<14> S2{G, (int)blockIdx.x, 8 * 256 * 64 * 2};
                pg8::EpiPart E2{(unsigned short*)(ws + WS_PART)};
                pg8::gemm_phase<pg8::EpiPart, pg8::CtxSplitOrder<14>, false, true, false, true>(lds, g2, S2, E2, nullptr);
                } SEAM(pb + 7);
            }
        } else {
            if (IN(pb + 4)) { PHASE_REP(pb + 4) { norm_phase<true>(a, lds, G, a.in[I_NFFN] + DM, modl, 3, 4, false, a.in[I_ROUTER], nullptr, nullptr, 0, false); } SEAM(pb + 4); }
            if (IN(pb + 5)) { slot_phase(a, lds, G); SEAM(pb + 5); }
            if (IN(pb + 6)) { PHASE_REP(pb + 6) {
                const int* TL = (const int*)(ws + WS_TILES);
                pg8::Gemm g{XN, (const bf16_t*)(ws + WS_WGU + SZ_WGU), DM / 2, SZ_WGU8, DM / 128};
                pg8::StaticOrder S; S.init(TL[0], NGU / 256, G, (int)blockIdx.x, 0);
#pragma unroll
                for (int e = 0; e < 8; ++e) S.ts[e] = TL[1 + e];
                pg8::EpiSwiglu8 E{(unsigned char*)HID, 1.0f / WSC_UP, HSC};
                pg8::gemm_phase<pg8::EpiSwiglu8, pg8::StaticOrder, true, true, true>(lds, g, S, E, (const int*)(ws + WS_ROWTOK));
                } SEAM(pb + 6);
            }
            if (IN(pb + 7)) { PHASE_REP(pb + 7) {
                const int* TL = (const int*)(ws + WS_TILES);
                pg8::Gemm g{HID, (const bf16_t*)(ws + WS_WD + SZ_WD), DFF / 2, SZ_WD8, DFF / 128};
                const int nmain = TL[0] < 128 ? TL[0] : 128, ntail = (TL[0] - nmain) * (DM / 256) * 2;
                pg8::StaticOrder S; S.init(nmain, DM / 256, G, (int)blockIdx.x, 0);
#pragma unroll
                for (int e = 0; e < 8; ++e) S.ts[e] = TL[1 + e];
                pg8::EpiMoeDown E{FP, (const int*)(ws + WS_ROWDST), (const float*)(ws + WS_ROWP), 1.0f / (WSC_DN * HSC), (bf16_t*)(ws + WS_FP2)};
                pg8::gemm_phase<pg8::EpiMoeDown, pg8::StaticOrder, false, true, true>(lds, g, S, E, nullptr);
                GRIDBAR();
                if ((int)blockIdx.x < ntail) {
                    pg8::TailSplitOrder S2; S2.S.init(TL[0] - nmain, 2 * (DM / 256), ntail, (int)blockIdx.x, 0); S2.S.pm0 = nmain; S2.kob = DFF / 2;
#pragma unroll
                    for (int e = 0; e < 8; ++e) S2.S.ts[e] = TL[1 + e];
                    pg8::Gemm g2 = g; g2.nt = DFF / 128 / 2;
                    pg8::gemm_phase<pg8::EpiMoeDown, pg8::TailSplitOrder, false, true, true>(lds, g2, S2, E, nullptr);
                } else final_phase(a, G - ntail, (int)blockIdx.x - ntail, 0);
                } SEAM(pb + 7);
            }
        }
        }
    if (IN(17)) { PHASE_REP(17) { final_phase(a, G, (int)blockIdx.x, 1); } }
#undef IN
#undef SEAM
#undef GRIDBAR
}

extern "C" void kernel_launch(void* const* d_in, const int* in_sizes, int n_in, void* d_out, int out_size, void* d_ws, size_t ws_size, hipStream_t stream) {
    static int grid = 0;
    if (grid == 0) {
        if (n_in != 23 || in_sizes[0] != NB * SEQ * DM || out_size != NB * SEQ * DM || ws_size < WS_END) {
            fprintf(stderr, "kernel_launch: unexpected shapes: n_in %d in0 %d out %d ws %zu (need %zu); nothing launched\n", n_in, n_in > 0 ? in_sizes[0] : -1, out_size, ws_size, (size_t)WS_END); grid = -1; return; }
        int dev = 0, cus = 0, per_cu = 0;
        if (hipGetDevice(&dev) != hipSuccess || hipDeviceGetAttribute(&cus, hipDeviceAttributeMultiprocessorCount, dev) != hipSuccess) { grid = -1; return; }
        if (hipFuncSetAttribute((const void*)mk_fwd, hipFuncAttributeMaxDynamicSharedMemorySize, LDS_BYTES) != hipSuccess) { fprintf(stderr, "kernel_launch: hipFuncSetAttribute failed\n"); grid = -1; return; }
        if (hipOccupancyMaxActiveBlocksPerMultiprocessor(&per_cu, (const void*)mk_fwd, NWAVES * 64, LDS_BYTES) != hipSuccess || per_cu < 1)
            fprintf(stderr, "kernel_launch: note: occupancy query reports %d workgroups per CU\n", per_cu);
        (void)hipGetLastError();
        grid = cus;
    }
    if (grid < 0) return;
    if (hipMemsetAsync((char*)d_ws + WS_CTL, 0, CTL_ZERO_BYTES, stream) != hipSuccess) return;
    Args a{};
    for (int i = 0; i < 23; ++i) a.in[i] = (const float*)d_in[i];
    a.out = (float*)d_out; a.ws = (unsigned char*)d_ws;
#if MK_PER_PHASE
    for (int p = 0; p < N_PHASES; ++p) { if (p == 6) continue; a.ph_lo = p; a.ph_hi = p + 1; hipLaunchKernelGGL(mk_fwd, dim3(grid), dim3(NWAVES * 64), LDS_BYTES, stream, a); }
#else
    a.ph_lo = 0; a.ph_hi = N_PHASES;
    hipLaunchKernelGGL(mk_fwd, dim3(grid), dim3(NWAVES * 64), LDS_BYTES, stream, a);
#endif
    const hipError_t le = hipPeekAtLastError();
    if (le != hipSuccess) fprintf(stderr, "kernel_launch: launch failed: %s\n", hipGetErrorName(le));
}
```

```cpp
#include <hip/hip_runtime.h>
#include <cstdio>
#include <cstdint>

#define LAS __attribute__((address_space(3)))
#define GAS __attribute__((address_space(1)))
typedef unsigned short bf16_t;
typedef short bf16x8 __attribute__((ext_vector_type(8)));
typedef short s16x4 __attribute__((ext_vector_type(4)));
typedef float f32x4 __attribute__((ext_vector_type(4)));
typedef float f32x2 __attribute__((ext_vector_type(2)));
typedef unsigned u32x4 __attribute__((ext_vector_type(4)));
typedef unsigned u32x2 __attribute__((ext_vector_type(2)));

constexpr int DM = 2048, NB = 2, SEQ = 8192, CTXL = 256, GRW = 64, GRH = 128, HD = 64;
constexpr int RPB = CTXL + SEQ;
constexpr int MROWS = NB * RPB;
constexpr int NPAN = MROWS / 256;
constexpr int DIN = 4352, DFF = 7168, NGU = 2 * DFF;
constexpr int NEXP = 8, NTOK = NB * SEQ;
constexpr int MAXSLOT = 2 * NTOK + NEXP * 256, MAXTILES = MAXSLOT / 256;
constexpr int C_QA = 0, C_KA = 512, C_VA = 1024, C_UB = 1536, C_GB = 2048, C_GC = 2560, C_XV = 3072, C_QD = 3584, C_KD = 4096, C_VD = 4224;
constexpr float EPS = 1e-6f;
constexpr float LOG2E = 1.4426950408889634f;
constexpr float QSCALE = 0.125f * LOG2E;

constexpr size_t MiB = 1u << 20;
constexpr size_t WS_CTL = 0, CTL_ZERO_BYTES = 1 * MiB;
constexpr size_t WS_MOD = 1 * MiB;
constexpr size_t WS_ROPE = 1 * MiB + 512 * 1024;
constexpr size_t WS_ROUTE = 2 * MiB;
constexpr size_t WS_SLOTS = 1 * MiB + 768 * 1024;
constexpr size_t WS_TAILF = 2 * MiB + 384 * 1024;
constexpr size_t WS_CNT = 2 * MiB + 512 * 1024;
constexpr size_t WS_ROWTOK = 3 * MiB;
constexpr size_t WS_ROWDST = 3 * MiB + 256 * 1024;
constexpr size_t WS_ROWP = 3 * MiB + 512 * 1024;
constexpr size_t WS_TILES = 3 * MiB + 768 * 1024;
constexpr size_t WS_WIN = 4 * MiB;
constexpr size_t SZ_WIN = (size_t)DIN * DM * 2;
constexpr size_t WS_WOUT = WS_WIN + 2 * SZ_WIN;
constexpr size_t SZ_WOUT = (size_t)DM * DM * 2;
constexpr size_t WS_WGU = WS_WOUT + 2 * SZ_WOUT;
constexpr size_t SZ_WGU = (size_t)NGU * DM * 2;
constexpr size_t SZ_WGU8 = (size_t)NGU * DM, SZ_WD8 = (size_t)DM * DFF;
constexpr float WSC_UP = 32.f, WSC_DN = 64.f, HSC = 4.f;
constexpr size_t WS_FP2 = WS_WGU + 32 * MiB;
constexpr size_t WS_WD = WS_WGU + 9 * SZ_WGU;
constexpr size_t SZ_WD = (size_t)DM * DFF * 2;
constexpr size_t WS_X = WS_WD + 9 * SZ_WD;
constexpr size_t SZ_X = (size_t)MROWS * DM * 4;
constexpr size_t WS_XN = WS_X + SZ_X;
constexpr size_t SZ_XN = (size_t)MROWS * DM * 2;
constexpr size_t WS_R = WS_XN + SZ_XN;
constexpr size_t WS_PROJ = WS_R;
constexpr size_t SZ_PROJ = (size_t)MROWS * DIN * 2;
constexpr size_t WS_CAT = WS_PROJ + SZ_PROJ;
constexpr size_t WS_HID = WS_R;
constexpr size_t SZ_HID = (size_t)MAXSLOT * DFF * 2;
constexpr size_t WS_FP = WS_HID + SZ_HID;
constexpr size_t SZ_FP = (size_t)2 * NTOK * DM * 2;
constexpr size_t WS_END = WS_FP + SZ_FP;
constexpr size_t WS_PART = WS_R + 232 * MiB;
static_assert(WS_PART >= WS_R + (size_t)MROWS * DFF * 2 && WS_PART >= WS_CAT + SZ_XN && WS_PART + (size_t)14 * 512 * DM * 4 <= WS_FP, "PART placement");
static_assert(WS_CAT + SZ_XN <= WS_FP, "overlay");
static_assert(WS_WIN % 256 == 0 && WS_X % 256 == 0 && WS_R % 256 == 0, "align");
constexpr int CW_BAR = 4096;
constexpr int CW_COLMAX = 32768;
constexpr int CW_COLMAX_IN = 49152;
constexpr size_t WS_COLSC_IN = 1 * MiB + 640 * 1024;
constexpr size_t WS_COLSC = 3 * MiB + 832 * 1024;
constexpr size_t WS_ROWSC = 3 * MiB + 896 * 1024;

#define RLX_AGENT __ATOMIC_RELAXED, __HIP_MEMORY_SCOPE_AGENT
__device__ __forceinline__ unsigned f2bf(float f) { unsigned u = __builtin_bit_cast(unsigned, f); return (u + 0x7fffu + ((u >> 16) & 1u)) >> 16; }
__device__ __forceinline__ unsigned pk2(float lo, float hi) { return f2bf(lo) | (f2bf(hi) << 16); }
__device__ __forceinline__ float bf2f(unsigned short h) { return __builtin_bit_cast(float, (unsigned)h << 16); }
__device__ __forceinline__ float bflo(unsigned w) { return __builtin_bit_cast(float, w << 16); }
__device__ __forceinline__ float bfhi(unsigned w) { return __builtin_bit_cast(float, w & 0xffff0000u); }
typedef _Float16 f16x2_t __attribute__((ext_vector_type(2)));
__device__ __forceinline__ unsigned pkh2(float lo, float hi) { const f16x2_t h = {(_Float16)lo, (_Float16)hi}; return __builtin_bit_cast(unsigned, h); }
__device__ __forceinline__ f32x4 unpk_h4(unsigned w0, unsigned w1) { const f16x2_t a = __builtin_bit_cast(f16x2_t, w0), b = __builtin_bit_cast(f16x2_t, w1); return (f32x4){(float)a[0], (float)a[1], (float)b[0], (float)b[1]}; }
__device__ __forceinline__ unsigned cvt_pk_bf16(float lo, float hi) { unsigned r; asm volatile("v_cvt_pk_bf16_f32 %0, %1, %2" : "=v"(r) : "v"(lo), "v"(hi)); return r; }
__device__ __forceinline__ float xadd16(float v) { const auto r = __builtin_amdgcn_permlane16_swap(__float_as_uint(v), __float_as_uint(v), false, false); return __uint_as_float(r[0]) + __uint_as_float(r[1]); }
__device__ __forceinline__ float xadd32(float v) { const auto r = __builtin_amdgcn_permlane32_swap(__float_as_uint(v), __float_as_uint(v), false, false); return __uint_as_float(r[0]) + __uint_as_float(r[1]); }
__device__ __forceinline__ float fmax2(float a, float b) { return __builtin_amdgcn_fmed3f(a, b, __builtin_inff()); }
__device__ __forceinline__ float xmax16(float v) { const auto r = __builtin_amdgcn_permlane16_swap(__float_as_uint(v), __float_as_uint(v), false, false); return fmax2(__uint_as_float(r[0]), __uint_as_float(r[1])); }
__device__ __forceinline__ float xmax32(float v) { const auto r = __builtin_amdgcn_permlane32_swap(__float_as_uint(v), __float_as_uint(v), false, false); return fmax2(__uint_as_float(r[0]), __uint_as_float(r[1])); }
__device__ __forceinline__ float wave_sum(float v) {
#pragma unroll
    for (int o = 1; o < 16; o <<= 1) v += __shfl_xor(v, o);
    return xadd32(xadd16(v));
}
__device__ __forceinline__ float fast_silu(float x) { return x * __builtin_amdgcn_rcpf(1.0f + __builtin_amdgcn_exp2f(-x * LOG2E)); }
__device__ __forceinline__ int opaque_tid() { int t = threadIdx.x; asm volatile("" : "+v"(t)); return t; }
__device__ __forceinline__ const float* in_row(const float* x, const float* ctx, int m) {
    const int b = m / RPB, r = m - b * RPB;
    return r < CTXL ? ctx + ((size_t)b * CTXL + r) * DM : x + ((size_t)b * SEQ + (r - CTXL)) * DM;
}
namespace pg8 {
constexpr int BM = 256, BK = 64, HALF = 128, HTB = HALF * BK * 2  , STAGE_BYTES = 8 * HTB, NXCD = 8, WGM = 8;
__host__ __device__ __forceinline__ int lds_byte(int r, int c) { const int st = (r >> 4) * 2 + (c >> 5), rr = r & 15, cc = c & 31, ob = rr * 64 + cc * 2; return st * 1024 + (ob ^ (((ob >> 9) & 1) << 5)); }
__host__ __device__ __forceinline__ void stage_rc(int b, int& R, int& C) { const int st = b / 1024, sb = b % 1024, swz = sb ^ (((sb >> 9) & 1) << 5); R = (st >> 1) * 16 + swz / 64; C = (st & 1) * 32 + (swz % 64) / 2; }
__host__ __device__ __forceinline__ int perm32(int rho) { const int n = rho >> 4, i = rho & 15; return 8 * (i >> 2) + 4 * n + (i & 3); }

typedef int v4i_t __attribute__((ext_vector_type(4))); typedef int v8i_t __attribute__((ext_vector_type(8)));
__device__ __forceinline__ v8i_t cat8(bf16x8 lo, bf16x8 hi) { return __builtin_shufflevector(__builtin_bit_cast(v4i_t, lo), __builtin_bit_cast(v4i_t, hi), 0, 1, 2, 3, 4, 5, 6, 7); }
struct Unit { int pm, pn, e, ko; };
struct Gemm { const bf16_t* A; const bf16_t* Bt; int K; size_t bstride; int nt; };

struct StaticOrder {
    int nM, nN, nwg, G, c, skipctx, wrap, pm0, wgm; int ts[8];
    __device__ void init(int nM_, int nN_, int G_, int c_, int skip_) { nM = nM_; nN = nN_; nwg = nM * nN; G = G_; c = c_; skipctx = skip_; wrap = 0; pm0 = 0; wgm = WGM;
#pragma unroll
        for (int e = 0; e < 8; ++e) ts[e] = 0x7fffffff; ts[0] = 0; }
    __device__ bool next(int i, Unit& u) const {
        const long L = (long)i * G + c; if (L >= nwg) return false;
        int wgid = (int)L; { const int q = nwg / NXCD, r = nwg % NXCD, xcd = wgid % NXCD, off = wgid / NXCD; wgid = (xcd < r ? xcd * (q + 1) : r * (q + 1) + (xcd - r) * q) + off; }
        const int nig = wgm * nN, gid = wgid / nig, fm = gid * wgm, gsz = (nM - fm) < wgm ? (nM - fm) : wgm;
        int pm = pm0 + fm + ((wgid % nig) % gsz); u.pn = (wgid % nig) / gsz;
        int e = 0;
#pragma unroll
        for (int k = 1; k < 8; ++k) e += (pm >= ts[k]) ? 1 : 0;
        u.e = e; u.ko = 0;
        if (skipctx) pm = pm + 1 + (pm >= 32 ? 1 : 0);
        if (wrap) pm = (pm % wrap) + 1;
        u.pm = pm; return true;
    }
};

struct TailSplitOrder {
    StaticOrder S; int kob;
    __device__ bool next(int i, Unit& u) const { if (!S.next(i, u)) return false; const int kh = u.pn >> 3; u.pn &= 7; u.ko = kh * kob; return true; }
};
template <int NS>
struct CtxSplitOrder {
    int G, c, kob;
    __device__ bool next(int i, Unit& u) const { const int L = i * G + c; if (L >= 16 * NS) return false; const int ks = L % NS, tile = L / NS; u.pn = tile & 7; u.pm = (tile >> 3) * 33; u.e = ks; u.ko = ks * kob; return true; }
};
#define PG8_SA(b, h) (((b) * 2 + (h)) * HTB)
#define PG8_SB(b, h) ((4 + (b) * 2 + (h)) * HTB)
#define PG8_STAGE(bufoff, gbase, voff) do { _Pragma("unroll") for (int _i = 0; _i < 2; ++_i) \
        __builtin_amdgcn_global_load_lds((const unsigned*)((const char*)(gbase) + (voff)[_i]), (LAS unsigned*)(lds + (bufoff) + ldsw + _i * 8192), 16, 0, 0); } while (0)
#define PG8_LDA(dst, b, h) do { _Pragma("unroll") for (int m = 0; m < 4; ++m) _Pragma("unroll") for (int k = 0; k < 2; ++k) dst[m][k] = *(const LAS bf16x8*)(lds + PG8_SA(b, h) + aoff + m * 2048 + k * 1024); } while (0)
#define PG8_LDB(dst, b, h) do { _Pragma("unroll") for (int n = 0; n < 2; ++n) _Pragma("unroll") for (int k = 0; k < 2; ++k) dst[n][k] = *(const LAS bf16x8*)(lds + PG8_SB(b, h) + boff + n * 2048 + k * 1024); } while (0)
#define PG8_MMA(ai, bj, At, Bt) do { __builtin_amdgcn_s_setprio(1); _Pragma("unroll") for (int m = 0; m < 4; ++m) _Pragma("unroll") for (int n = 0; n < 2; ++n) _Pragma("unroll") for (int k = 0; k < 2; ++k) \
        acc[ai][bj][m][n] = __builtin_amdgcn_mfma_f32_16x16x32_bf16(Bt[n][k], At[m][k], acc[ai][bj][m][n], 0, 0, 0); __builtin_amdgcn_s_setprio(0); } while (0)
#define PG8_MMA8(ai, bj, At, Bt) do { __builtin_amdgcn_s_setprio(1); _Pragma("unroll") for (int m = 0; m < 4; ++m) _Pragma("unroll") for (int n = 0; n < 2; ++n) \
        asm volatile("v_mfma_scale_f32_16x16x128_f8f6f4 %0, %1, %2, %0, %3, %3 op_sel_hi:[0,0,0]" : "+v"(acc[ai][bj][m][n]) : "v"(cat8(Bt[n][0], Bt[n][1])), "v"(cat8(At[m][0], At[m][1])), "v"(one_scale)); __builtin_amdgcn_s_setprio(0); } while (0)
#define PG8_MMAI(ai, bj, At, Bt) do { __builtin_amdgcn_s_setprio(1); _Pragma("unroll") for (int m = 0; m < 4; ++m) _Pragma("unroll") for (int n = 0; n < 2; ++n) _Pragma("unroll") for (int k = 0; k < 2; ++k) \
        acc[ai][bj][m][n] = __builtin_bit_cast(f32x4, __builtin_amdgcn_mfma_i32_16x16x64_i8(__builtin_bit_cast(v4i_t, Bt[n][k]), __builtin_bit_cast(v4i_t, At[m][k]), __builtin_bit_cast(v4i_t, acc[ai][bj][m][n]), 0, 0, 0)); __builtin_amdgcn_s_setprio(0); } while (0)
#define PG8_MM(ai, bj, At, Bt) do { if constexpr (F8) PG8_MMA8(ai, bj, At, Bt); else if constexpr (Epi::I8) PG8_MMAI(ai, bj, At, Bt); else PG8_MMA(ai, bj, At, Bt); } while (0)
#define PG8_WAIT_V(n) asm volatile("s_waitcnt vmcnt(" #n ")" ::: "memory")
#define PG8_WAIT_L(n) asm volatile("s_waitcnt lgkmcnt(" #n ")" ::: "memory")
#define PG8_BAR __builtin_amdgcn_s_barrier()
#define PG8_SCHED __builtin_amdgcn_sched_barrier(0)

template <class Epi, class Sched, bool GATHER, bool ALIGN_EPI, bool F8 = false, bool BLK = false>
__device__ __forceinline__ void gemm_phase(LAS unsigned char* lds, const Gemm g, const Sched& S, const Epi& E, const int* __restrict__ rowtok) {
    const int tid = opaque_tid(), wid = __builtin_amdgcn_readfirstlane(tid >> 6), lane = tid & 63, wr = wid >> 2, wc = wid & 3, fr = lane & 15, fq = lane >> 4;
    const int K = g.K, nt = g.nt;
    unsigned voffB[2]; int RA[2], CA[2];
#pragma unroll
    for (int i = 0; i < 2; ++i) { int R, C; stage_rc(tid * 16 + i * 8192, R, C); const int Rb = Epi::PERM ? ((R & ~31) + perm32(R & 31)) : R;
        RA[i] = R; CA[i] = C; voffB[i] = (unsigned)(Rb * (BLK ? BK : K) + C) * 2u; }
    const size_t kstep = BLK ? (size_t)(BM * BK * 2) : (size_t)(BK * 2);
    const size_t hstep = BLK ? (size_t)(HALF * BK * 2) : (size_t)HALF * K * 2;
    const size_t tstep = (size_t)BM * K * 2;
    const unsigned ldsw = (unsigned)wid * 1024u;
    const int aoff = lds_byte(wr * 64 + fr, fq * 8), boff = lds_byte(wc * 32 + fr, fq * 8);
#define PG8_SETA(v, u) do { _Pragma("unroll") for (int _h = 0; _h < 2; ++_h) _Pragma("unroll") for (int _i = 0; _i < 2; ++_i) { \
        int _row = (u).pm * BM + _h * HALF + RA[_i]; if constexpr (GATHER) _row = rowtok[_row]; \
        v[_h][_i] = BLK ? (unsigned)((_row >> 8) * (BM * K) + (_row & 255) * BK + CA[_i]) * 2u : (unsigned)(_row * K + CA[_i]) * 2u; } } while (0)
    Unit cur, nxt, nn; int ui = 0;
    if (!S.next(0, cur)) return;
    bool has_next = S.next(1, nxt);
    unsigned vA[2][2], vN[2][2];
    PG8_SETA(vA, cur);
    if (has_next) PG8_SETA(vN, nxt); else { _Pragma("unroll") for (int h = 0; h < 2; ++h) _Pragma("unroll") for (int i = 0; i < 2; ++i) vN[h][i] = vA[h][i]; }
    f32x4 acc[2][2][4][2];
#pragma unroll
    for (int a = 0; a < 2; ++a)
#pragma unroll
        for (int b = 0; b < 2; ++b)
#pragma unroll
            for (int m = 0; m < 4; ++m)
#pragma unroll
                for (int n = 0; n < 2; ++n) acc[a][b][m][n] = (f32x4){0.f, 0.f, 0.f, 0.f};
    bf16x8 At[4][2], B0[2][2], B1[2][2];
    const int one_scale = 0x7f7f7f7f;
    const char* cA = (const char*)g.A + cur.ko;
    const char* cB = (const char*)g.Bt + (size_t)cur.e * g.bstride + (size_t)cur.pn * tstep + cur.ko;
    PG8_STAGE(PG8_SB(0, 0), cB, voffB); PG8_STAGE(PG8_SB(0, 1), cB + hstep, voffB); PG8_STAGE(PG8_SA(0, 0), cA, vA[0]); PG8_STAGE(PG8_SA(0, 1), cA, vA[1]);
    if (wr == 1) PG8_BAR;
    PG8_WAIT_V(2); PG8_BAR;
    PG8_STAGE(PG8_SB(1, 0), cB + kstep, voffB); PG8_STAGE(PG8_SA(1, 0), cA + kstep, vA[0]); PG8_STAGE(PG8_SB(1, 1), cB + hstep + kstep, voffB);
    PG8_WAIT_V(6); PG8_BAR;
    for (;;) {
        const char* nB = has_next ? (const char*)g.Bt + (size_t)nxt.e * g.bstride + (size_t)nxt.pn * tstep + nxt.ko : cB;
        const char* nA = has_next ? (const char*)g.A + nxt.ko : cA;
        for (int t = 0; t < nt; t += 2) {
            const bool last = (t == nt - 2);
            const char* a1 = cA + (size_t)(t + 1) * kstep;
            const char* a2 = last ? nA : cA + (size_t)(t + 2) * kstep; const char* b2 = last ? nB : cB + (size_t)(t + 2) * kstep;
            const char* a3 = a2 + kstep; const char* b3 = b2 + kstep;
            unsigned v2[2][2];
#pragma unroll
            for (int h = 0; h < 2; ++h)
#pragma unroll
                for (int i = 0; i < 2; ++i) v2[h][i] = last ? vN[h][i] : vA[h][i];
            PG8_LDB(B0, 0, 0); PG8_LDB(B1, 0, 1); PG8_SCHED; PG8_LDA(At, 0, 0); PG8_STAGE(PG8_SA(1, 1), a1, vA[1]);
            PG8_WAIT_V(8); PG8_WAIT_L(0); PG8_BAR; PG8_MM(0, 0, At, B0); PG8_MM(0, 1, At, B1); PG8_BAR; PG8_SCHED;
            PG8_LDA(At, 0, 1); PG8_STAGE(PG8_SB(0, 0), b2, voffB); PG8_STAGE(PG8_SB(0, 1), b2 + hstep, voffB); PG8_STAGE(PG8_SA(0, 0), a2, v2[0]);
            PG8_WAIT_V(8); PG8_WAIT_L(0); PG8_BAR; PG8_MM(1, 0, At, B0); PG8_MM(1, 1, At, B1); PG8_BAR; PG8_SCHED;
            PG8_LDB(B0, 1, 0); PG8_LDB(B1, 1, 1); PG8_SCHED; PG8_LDA(At, 1, 0); PG8_STAGE(PG8_SA(0, 1), a2, v2[1]);
            PG8_WAIT_V(8); PG8_WAIT_L(0); PG8_BAR; PG8_MM(0, 0, At, B0); PG8_MM(0, 1, At, B1); PG8_BAR; PG8_SCHED;
            PG8_LDA(At, 1, 1); PG8_STAGE(PG8_SB(1, 0), b3, voffB); PG8_STAGE(PG8_SB(1, 1), b3 + hstep, voffB); PG8_STAGE(PG8_SA(1, 0), a3, v2[0]);
            PG8_WAIT_V(8); PG8_WAIT_L(0); PG8_BAR; PG8_MM(1, 0, At, B0); PG8_MM(1, 1, At, B1); PG8_BAR; PG8_SCHED;
        }
        if constexpr (ALIGN_EPI) { if (wr == 0) PG8_BAR; }
        if constexpr (F8) { asm volatile("s_nop 15\n\ts_nop 15" ::: "memory");
            _Pragma("unroll") for (int a_ = 0; a_ < 2; ++a_) _Pragma("unroll") for (int b_ = 0; b_ < 2; ++b_) _Pragma("unroll") for (int m_ = 0; m_ < 4; ++m_) _Pragma("unroll") for (int n_ = 0; n_ < 2; ++n_) asm volatile("" : "+v"(acc[a_][b_][m_][n_])); }
        E(acc, cur, wr, wc, fr, fq);
        if (!has_next) break;
#pragma unroll
        for (int a = 0; a < 2; ++a)
#pragma unroll
            for (int b = 0; b < 2; ++b)
#pragma unroll
                for (int m = 0; m < 4; ++m)
#pragma unroll
                    for (int n = 0; n < 2; ++n) acc[a][b][m][n] = (f32x4){0.f, 0.f, 0.f, 0.f};
        cur = nxt; cB = nB; cA = nA; ++ui;
#pragma unroll
        for (int h = 0; h < 2; ++h)
#pragma unroll
            for (int i = 0; i < 2; ++i) vA[h][i] = vN[h][i];
        has_next = S.next(ui + 1, nn);
        if (has_next) { nxt = nn; PG8_SETA(vN, nxt); }
        if constexpr (ALIGN_EPI) { if (wr == 1) PG8_BAR; }
    }
    PG8_WAIT_V(0);
    if constexpr (!ALIGN_EPI) { if (wr == 0) PG8_BAR; }
    PG8_BAR;
#undef PG8_SETA
}


struct EpiProj {
    static constexpr bool PERM = true, IDEMP = true, I8 = false;
    bf16_t* P; const f32x2* rope;
    __device__ __forceinline__ void operator()(const f32x4 (&acc)[2][2][4][2], const Unit& u, int wr, int wc, int fr, int fq) const {
        const int pn = u.pn; const bool ctxp = (u.pm % 33) == 0;
        const int row0 = u.pm * BM + wr * 64 + fr;
#pragma unroll
        for (int bj = 0; bj < 2; ++bj) {
            const int cN = pn * BM + bj * HALF + wc * 32 + 8 * fq;
            const bool isrope = (pn == 14) || (pn == 15) || (pn == 16 && bj == 0);
            const float sc = (pn < 2 || pn == 14 || pn == 15) ? QSCALE : 1.0f;
            if (!isrope) {
#pragma unroll
                for (int ai = 0; ai < 2; ++ai)
#pragma unroll
                    for (int m = 0; m < 4; ++m) { const f32x4 v0 = acc[ai][bj][m][0] * sc, v1 = acc[ai][bj][m][1] * sc;
                        u32x4 w; w.x = cvt_pk_bf16(v0[0], v0[1]); w.y = cvt_pk_bf16(v0[2], v0[3]); w.z = cvt_pk_bf16(v1[0], v1[1]); w.w = cvt_pk_bf16(v1[2], v1[3]);
                        *(u32x4*)(P + (size_t)(row0 + ai * HALF + m * 16) * DIN + cN) = w; }
            } else {
                const int hrel = (wc & 1) * 32 + 8 * fq, hb = cN - hrel, a = hrel >> 3;
#pragma unroll
                for (int ai = 0; ai < 2; ++ai)
#pragma unroll
                    for (int m = 0; m < 4; ++m) { const int row = row0 + ai * HALF + m * 16;
                        f32x4 x1 = acc[ai][bj][m][0], x2 = acc[ai][bj][m][1], o1, o2;
                        if (!ctxp) { const int t = (row % RPB) - CTXL; const int pos = (wc & 1) ? (t & 63) : (t >> 6);
                            const f32x4* cs = (const f32x4*)(rope + pos * 16 + 4 * fq); const f32x4 c01 = cs[0], c23 = cs[1];
                            o1[0] = x1[0] * c01[0] - x2[0] * c01[1]; o2[0] = x1[0] * c01[1] + x2[0] * c01[0];
                            o1[1] = x1[1] * c01[2] - x2[1] * c01[3]; o2[1] = x1[1] * c01[3] + x2[1] * c01[2];
                            o1[2] = x1[2] * c23[0] - x2[2] * c23[1]; o2[2] = x1[2] * c23[1] + x2[2] * c23[0];
                            o1[3] = x1[3] * c23[2] - x2[3] * c23[3]; o2[3] = x1[3] * c23[3] + x2[3] * c23[2];
                        } else { o1 = x1; o2 = x2; }
                        o1 = o1 * sc; o2 = o2 * sc;
                        u32x2 w1, w2; w1.x = cvt_pk_bf16(o1[0], o1[1]); w1.y = cvt_pk_bf16(o1[2], o1[3]); w2.x = cvt_pk_bf16(o2[0], o2[1]); w2.y = cvt_pk_bf16(o2[2], o2[3]);
                        bf16_t* rp = P + (size_t)row * DIN + hb + 4 * a;
                        *(u32x2*)(rp) = w1; *(u32x2*)(rp + 32) = w2; }
            }
        }
    }
};
struct EpiProjI8 {
    static constexpr bool PERM = true, IDEMP = true, I8 = true;
    bf16_t* P; const f32x2* rope; const float* rowsc; const float* colsc;
    __device__ __forceinline__ void operator()(const f32x4 (&acc)[2][2][4][2], const Unit& u, int wr, int wc, int fr, int fq) const {
        const int pn = u.pn; const bool ctxp = (u.pm % 33) == 0;
        const int row0 = u.pm * BM + wr * 64 + fr;
        float rsv[2][4];
#pragma unroll
        for (int ai = 0; ai < 2; ++ai)
#pragma unroll
            for (int m = 0; m < 4; ++m) rsv[ai][m] = rowsc[row0 + ai * HALF + m * 16];
        f32x4 csv[2][2];
#pragma unroll
        for (int bj = 0; bj < 2; ++bj) { const int cN = pn * BM + bj * HALF + wc * 32 + 8 * fq; csv[bj][0] = *(const f32x4*)(colsc + cN); csv[bj][1] = *(const f32x4*)(colsc + cN + 4); }
        asm volatile("" ::: "memory");
#pragma unroll
        for (int bj = 0; bj < 2; ++bj) {
            const int cN = pn * BM + bj * HALF + wc * 32 + 8 * fq;
            const f32x4 cs0 = csv[bj][0], cs1 = csv[bj][1];
            const bool isrope = (pn == 14) || (pn == 15) || (pn == 16 && bj == 0);
            const float sc = (pn < 2 || pn == 14 || pn == 15) ? QSCALE : 1.0f;
            if (!isrope) {
#pragma unroll
                for (int ai = 0; ai < 2; ++ai)
#pragma unroll
                    for (int m = 0; m < 4; ++m) { const float rs = rsv[ai][m] * sc; f32x4 v0, v1;
                        _Pragma("unroll") for (int k = 0; k < 4; ++k) { v0[k] = (float)__float_as_int(acc[ai][bj][m][0][k]) * (rs * cs0[k]); v1[k] = (float)__float_as_int(acc[ai][bj][m][1][k]) * (rs * cs1[k]); }
                        u32x4 w; w.x = cvt_pk_bf16(v0[0], v0[1]); w.y = cvt_pk_bf16(v0[2], v0[3]); w.z = cvt_pk_bf16(v1[0], v1[1]); w.w = cvt_pk_bf16(v1[2], v1[3]);
                        *(u32x4*)(P + (size_t)(row0 + ai * HALF + m * 16) * DIN + cN) = w; }
            } else {
                const int hrel = (wc & 1) * 32 + 8 * fq, hb = cN - hrel, a = hrel >> 3;
#pragma unroll
                for (int ai = 0; ai < 2; ++ai) {
                    f32x4 rc01[4], rc23[4];
                    if (!ctxp) {
#pragma unroll
                        for (int m = 0; m < 4; ++m) { const int row = row0 + ai * HALF + m * 16; const int t = (row % RPB) - CTXL; const int pos = (wc & 1) ? (t & 63) : (t >> 6);
                            const f32x4* cs = (const f32x4*)(rope + pos * 16 + 4 * fq); rc01[m] = cs[0]; rc23[m] = cs[1]; } }
                    asm volatile("" ::: "memory");
#pragma unroll
                    for (int m = 0; m < 4; ++m) { const int row = row0 + ai * HALF + m * 16;
                        const float rs = rsv[ai][m]; f32x4 x1, x2, o1, o2;
                        _Pragma("unroll") for (int k = 0; k < 4; ++k) { x1[k] = (float)__float_as_int(acc[ai][bj][m][0][k]) * (rs * cs0[k]); x2[k] = (float)__float_as_int(acc[ai][bj][m][1][k]) * (rs * cs1[k]); }
                        if (!ctxp) { const f32x4 c01 = rc01[m], c23 = rc23[m];
                            o1[0] = x1[0] * c01[0] - x2[0] * c01[1]; o2[0] = x1[0] * c01[1] + x2[0] * c01[0];
                            o1[1] = x1[1] * c01[2] - x2[1] * c01[3]; o2[1] = x1[1] * c01[3] + x2[1] * c01[2];
                            o1[2] = x1[2] * c23[0] - x2[2] * c23[1]; o2[2] = x1[2] * c23[1] + x2[2] * c23[0];
                            o1[3] = x1[3] * c23[2] - x2[3] * c23[3]; o2[3] = x1[3] * c23[3] + x2[3] * c23[2];
                        } else { o1 = x1; o2 = x2; }
                        o1 = o1 * sc; o2 = o2 * sc;
                        u32x2 w1, w2; w1.x = cvt_pk_bf16(o1[0], o1[1]); w1.y = cvt_pk_bf16(o1[2], o1[3]); w2.x = cvt_pk_bf16(o2[0], o2[1]); w2.y = cvt_pk_bf16(o2[2], o2[3]);
                        bf16_t* rp = P + (size_t)row * DIN + hb + 4 * a;
                        *(u32x2*)(rp) = w1; *(u32x2*)(rp + 32) = w2; }
                }
            }
        }
    }
};
struct EpiResid {
    static constexpr bool PERM = true, IDEMP = false, I8 = false;
    unsigned short* X; const float* xin; const float* cin; const float* gate; int from_inputs; unsigned short* Xw;
    __device__ __forceinline__ void operator()(const f32x4 (&acc)[2][2][4][2], const Unit& u, int wr, int wc, int fr, int fq) const {
        const int b = u.pm / 33; const bool ctxp = (u.pm % 33) == 0; const float* gp = gate + (ctxp ? 2 : b) * 12288;
        const int col0 = u.pn * BM + wc * 32 + 8 * fq;
        f32x4 gv[2][2];
#pragma unroll
        for (int bj = 0; bj < 2; ++bj)
#pragma unroll
            for (int n = 0; n < 2; ++n) gv[bj][n] = *(const f32x4*)(gp + col0 + bj * HALF + 4 * n);
#pragma unroll
        for (int ai = 0; ai < 2; ++ai)
#pragma unroll
            for (int mp = 0; mp < 2; ++mp) {
                f32x4 r0[2][2], r1[2][2]; unsigned short* dst[2];
#pragma unroll
                for (int mm = 0; mm < 2; ++mm) { const int row = u.pm * BM + ai * HALF + wr * 64 + (2 * mp + mm) * 16 + fr;
                    const float* srcf = in_row(xin, cin, row); const unsigned short* srch = X + (size_t)row * DM; dst[mm] = Xw + (size_t)row * DM;
#pragma unroll
                    for (int bj = 0; bj < 2; ++bj) { const int c = col0 + bj * HALF;
                        if (from_inputs) { r0[mm][bj] = *(const f32x4*)(srcf + c); r1[mm][bj] = *(const f32x4*)(srcf + c + 4); }
                        else { const u32x4 w = *(const u32x4*)(srch + c); r0[mm][bj] = unpk_h4(w.x, w.y); r1[mm][bj] = unpk_h4(w.z, w.w); } } }
                asm volatile("" ::: "memory");
#pragma unroll
                for (int mm = 0; mm < 2; ++mm)
#pragma unroll
                    for (int bj = 0; bj < 2; ++bj) { const int c = col0 + bj * HALF, m = 2 * mp + mm;
                        const f32x4 o0 = r0[mm][bj] + gv[bj][0] * acc[ai][bj][m][0], o1 = r1[mm][bj] + gv[bj][1] * acc[ai][bj][m][1];
                        u32x4 ow; ow.x = pkh2(o0[0], o0[1]); ow.y = pkh2(o0[2], o0[3]); ow.z = pkh2(o1[0], o1[1]); ow.w = pkh2(o1[2], o1[3]);
                        *(u32x4*)(dst[mm] + c) = ow; }
                asm volatile("" ::: "memory");
            }
    }
};
struct EpiPart {
    static constexpr bool PERM = true, IDEMP = true, I8 = false;
    unsigned short* PART;
    __device__ __forceinline__ void operator()(const f32x4 (&acc)[2][2][4][2], const Unit& u, int wr, int wc, int fr, int fq) const {
        const int col0 = u.pn * BM + wc * 32 + 8 * fq; unsigned short* base = PART + ((size_t)u.e * 512 + (u.pm ? 256 : 0)) * DM;
#pragma unroll
        for (int ai = 0; ai < 2; ++ai)
#pragma unroll
            for (int m = 0; m < 4; ++m) { unsigned short* dst = base + (size_t)(ai * HALF + wr * 64 + m * 16 + fr) * DM + col0;
#pragma unroll
                for (int bj = 0; bj < 2; ++bj) { const f32x4 a0 = acc[ai][bj][m][0], a1 = acc[ai][bj][m][1];
                    u32x4 w; w.x = pkh2(a0[0], a0[1]); w.y = pkh2(a0[2], a0[3]); w.z = pkh2(a1[0], a1[1]); w.w = pkh2(a1[2], a1[3]);
                    *(u32x4*)(dst + bj * HALF) = w; } }
    }
};
struct EpiSwiglu {
    static constexpr bool PERM = true, IDEMP = true, I8 = false;
    bf16_t* H;
    __device__ __forceinline__ void operator()(const f32x4 (&acc)[2][2][4][2], const Unit& u, int wr, int wc, int fr, int fq) const {
        const int row0 = wr * 64 + fr; bf16_t* Hb = H + (size_t)u.pm * (BM * DFF) + (size_t)(2 * u.pn + (wc >> 1)) * (BM * BK) + (wc & 1) * 32 + 8 * fq;
#pragma unroll
        for (int ai = 0; ai < 2; ++ai)
#pragma unroll
            for (int m = 0; m < 4; ++m) { f32x4 h0, h1;
#pragma unroll
                for (int k = 0; k < 4; ++k) { h0[k] = fast_silu(acc[ai][0][m][0][k]) * acc[ai][1][m][0][k]; h1[k] = fast_silu(acc[ai][0][m][1][k]) * acc[ai][1][m][1][k]; }
                u32x4 w; w.x = cvt_pk_bf16(h0[0], h0[1]); w.y = cvt_pk_bf16(h0[2], h0[3]); w.z = cvt_pk_bf16(h1[0], h1[1]); w.w = cvt_pk_bf16(h1[2], h1[3]);
                *(u32x4*)(Hb + (row0 + ai * HALF + m * 16) * BK) = w; }
    }
};
struct EpiSwigluI8 {
    static constexpr bool PERM = true, IDEMP = true, I8 = true;
    bf16_t* H; const float* rowsc; const float* colsc;
    __device__ __forceinline__ void operator()(const f32x4 (&acc)[2][2][4][2], const Unit& u, int wr, int wc, int fr, int fq) const {
        const int row0 = wr * 64 + fr; bf16_t* Hb = H + (size_t)u.pm * (BM * DFF) + (size_t)(2 * u.pn + (wc >> 1)) * (BM * BK) + (wc & 1) * 32 + 8 * fq;
        const int cN = u.pn * BM + wc * 32 + 8 * fq;
        const f32x4 cg0 = *(const f32x4*)(colsc + cN), cg1 = *(const f32x4*)(colsc + cN + 4), cu0 = *(const f32x4*)(colsc + cN + HALF), cu1 = *(const f32x4*)(colsc + cN + HALF + 4);
        float rsv[2][4];
#pragma unroll
        for (int ai = 0; ai < 2; ++ai)
#pragma unroll
            for (int m = 0; m < 4; ++m) rsv[ai][m] = rowsc[u.pm * BM + row0 + ai * HALF + m * 16];
        asm volatile("" ::: "memory");
#pragma unroll
        for (int ai = 0; ai < 2; ++ai)
#pragma unroll
            for (int m = 0; m < 4; ++m) { const float rs = rsv[ai][m]; f32x4 h0, h1;
#pragma unroll
                for (int k = 0; k < 4; ++k) {
                    const float g0 = (float)__float_as_int(acc[ai][0][m][0][k]) * (rs * cg0[k]), u0 = (float)__float_as_int(acc[ai][1][m][0][k]) * (rs * cu0[k]);
                    const float g1 = (float)__float_as_int(acc[ai][0][m][1][k]) * (rs * cg1[k]), u1 = (float)__float_as_int(acc[ai][1][m][1][k]) * (rs * cu1[k]);
                    h0[k] = fast_silu(g0) * u0; h1[k] = fast_silu(g1) * u1;
                }
                u32x4 w; w.x = cvt_pk_bf16(h0[0], h0[1]); w.y = cvt_pk_bf16(h0[2], h0[3]); w.z = cvt_pk_bf16(h1[0], h1[1]); w.w = cvt_pk_bf16(h1[2], h1[3]);
                *(u32x4*)(Hb + (row0 + ai * HALF + m * 16) * BK) = w; }
    }
};
struct EpiMoeDown {
    static constexpr bool PERM = true, IDEMP = true, I8 = false;
    bf16_t* FP; const int* rowdst; const float* rowp; float sc; bf16_t* FP2;
    __device__ __forceinline__ void operator()(const f32x4 (&acc)[2][2][4][2], const Unit& u, int wr, int wc, int fr, int fq) const {
        const int col0 = u.pn * BM + wc * 32 + 8 * fq;
        int dstv[2][4]; float pv[2][4];
#pragma unroll
        for (int ai = 0; ai < 2; ++ai)
#pragma unroll
            for (int m = 0; m < 4; ++m) { const int slot = u.pm * BM + ai * HALF + wr * 64 + m * 16 + fr; const int d_ = rowdst[slot]; dstv[ai][m] = (u.ko != 0 && d_ >= 0) ? slot - 128 * BM : d_; pv[ai][m] = rowp[slot]; }
        asm volatile("" ::: "memory");
#pragma unroll
        for (int ai = 0; ai < 2; ++ai)
#pragma unroll
            for (int m = 0; m < 4; ++m) { const int dst = dstv[ai][m]; const float p = pv[ai][m] * sc;
                if (dst >= 0) { bf16_t* rp = (u.ko != 0 ? FP2 : FP) + (size_t)dst * DM + col0;
#pragma unroll
                    for (int bj = 0; bj < 2; ++bj) { const f32x4 v0 = acc[ai][bj][m][0] * p, v1 = acc[ai][bj][m][1] * p;
                        u32x4 w; w.x = cvt_pk_bf16(v0[0], v0[1]); w.y = cvt_pk_bf16(v0[2], v0[3]); w.z = cvt_pk_bf16(v1[0], v1[1]); w.w = cvt_pk_bf16(v1[2], v1[3]); *(u32x4*)(rp + bj * HALF) = w; } } }
    }
};
__device__ __forceinline__ unsigned pk_fp8x4(float a, float b, float c, float d) {
    a = __builtin_amdgcn_fmed3f(a, -448.f, 448.f); b = __builtin_amdgcn_fmed3f(b, -448.f, 448.f); c = __builtin_amdgcn_fmed3f(c, -448.f, 448.f); d = __builtin_amdgcn_fmed3f(d, -448.f, 448.f);
    int w = 0; w = __builtin_amdgcn_cvt_pk_fp8_f32(a, b, w, false); w = __builtin_amdgcn_cvt_pk_fp8_f32(c, d, w, true); return (unsigned)w; }
struct EpiSwiglu8 {
    static constexpr bool PERM = true, IDEMP = true, I8 = false;
    unsigned char* H; float ws_inv, hs;
    __device__ __forceinline__ void operator()(const f32x4 (&acc)[2][2][4][2], const Unit& u, int wr, int wc, int fr, int fq) const {
        const int row0 = u.pm * BM + wr * 64 + fr, col = u.pn * HALF + wc * 32 + 8 * fq;
        const float k1 = -ws_inv * LOG2E, ic = 1.0f / (ws_inv * ws_inv * hs);
#pragma unroll
        for (int ai = 0; ai < 2; ++ai)
#pragma unroll
            for (int m = 0; m < 4; ++m) { f32x4 h0, h1;
#pragma unroll
                for (int n = 0; n < 2; ++n) {
                    const f32x4 gq = acc[ai][0][m][n], uq = acc[ai][1][m][n];
                    const f32x4 tq = gq * k1, pq = gq * uq;
                    f32x4 eq; eq[0] = __builtin_amdgcn_exp2f(tq[0]); eq[1] = __builtin_amdgcn_exp2f(tq[1]); eq[2] = __builtin_amdgcn_exp2f(tq[2]); eq[3] = __builtin_amdgcn_exp2f(tq[3]);
                    const f32x4 dq = eq * ic + ic;
                    f32x4 rq; rq[0] = __builtin_amdgcn_rcpf(dq[0]); rq[1] = __builtin_amdgcn_rcpf(dq[1]); rq[2] = __builtin_amdgcn_rcpf(dq[2]); rq[3] = __builtin_amdgcn_rcpf(dq[3]);
                    const f32x4 hq = pq * rq;
                    if (n == 0) h0 = hq; else h1 = hq; }
                u32x2 w; w.x = pk_fp8x4(h0[0], h0[1], h0[2], h0[3]); w.y = pk_fp8x4(h1[0], h1[1], h1[2], h1[3]);
                *(u32x2*)(H + (size_t)(row0 + ai * HALF + m * 16) * DFF + col) = w; }
    }
};
}
namespace att {
constexpr int PITCH = 144, TILE = 64 * PITCH, BUF = 2 * TILE;
typedef short v4i16_t __attribute__((ext_vector_type(4)));
struct St { f32x4 o[4]; float m, l; };
__device__ __forceinline__ s16x4 vtr(const LAS char* p) { return __builtin_bit_cast(s16x4, __builtin_amdgcn_ds_read_tr16_b64_v4i16((LAS v4i16_t*)p)); }
__device__ __forceinline__ float fexp2(float x) { return __builtin_amdgcn_exp2f(x); }

template <int MODE>
__device__ __forceinline__ void chunk(const LAS char* kt, const LAS char* vt, const bf16x8 (&qf)[2], St& st, int lane, int pa, int pb, const LAS float* bias, const int (&bidx)[8], const bool (&bok)[8]) {
    const int mrow = lane & 15, g = lane >> 4;
    f32x4 s[2];
#pragma unroll
    for (int b = 0; b < 2; ++b) {
        const int krow = 8 * (mrow >> 2) + 4 * b + (mrow & 3);
        const LAS char* kp = kt + krow * PITCH + 16 * g;
        const bf16x8 a0 = *(const LAS bf16x8*)kp, a1 = *(const LAS bf16x8*)(kp + 64);
        f32x4 z = (f32x4){0.f, 0.f, 0.f, 0.f};
        z = __builtin_amdgcn_mfma_f32_16x16x32_bf16(a0, qf[0], z, 0, 0, 0);
        z = __builtin_amdgcn_mfma_f32_16x16x32_bf16(a1, qf[1], z, 0, 0, 0);
        s[b] = z;
    }
    float p[8]; float mx = -1e30f;
    const unsigned t0 = MODE == 2 ? (unsigned)(pa + 8 * g) : 0u, span = MODE == 2 ? (unsigned)pb : 0u;
#pragma unroll
    for (int b = 0; b < 2; ++b)
#pragma unroll
        for (int i = 0; i < 4; ++i) {
            float v = s[b][i];
            if (MODE == 1) { v += bias[bidx[4 * b + i]]; v = bok[4 * b + i] ? v : -1e30f; }
            if (MODE == 2) v = (t0 + (unsigned)(4 * b + i)) <= span ? v : -1e30f;
            p[4 * b + i] = v;
        }
    mx = fmax2(fmax2(fmax2(p[0], p[1]), fmax2(p[2], p[3])), fmax2(fmax2(p[4], p[5]), fmax2(p[6], p[7])));
    mx = xmax32(xmax16(mx));
    const float mn = fmax2(st.m, mx);
    const float alpha = fexp2(st.m - mn);
    float rs = 0.f;
#pragma unroll
    for (int k = 0; k < 8; ++k) { const float e = fexp2(p[k] - mn); p[k] = e; rs += e; }
    st.l = st.l * alpha + rs; st.m = mn;
#pragma unroll
    for (int d = 0; d < 4; ++d) st.o[d] = st.o[d] * alpha;
    u32x4 pw; pw.x = cvt_pk_bf16(p[0], p[1]); pw.y = cvt_pk_bf16(p[2], p[3]); pw.z = cvt_pk_bf16(p[4], p[5]); pw.w = cvt_pk_bf16(p[6], p[7]);
    const bf16x8 pbv = __builtin_bit_cast(bf16x8, pw);
    const LAS char* vp = vt + (8 * g + (mrow >> 2)) * PITCH + (mrow & 3) * 8;
#pragma unroll
    for (int d = 0; d < 4; ++d) {
        const s16x4 lo = vtr(vp + d * 32), hi = vtr(vp + d * 32 + 4 * PITCH);
        const bf16x8 af = (bf16x8){lo[0], lo[1], lo[2], lo[3], hi[0], hi[1], hi[2], hi[3]};
        st.o[d] = __builtin_amdgcn_mfma_f32_16x16x32_bf16(af, pbv, st.o[d], 0, 0, 0);
    }
}
template <int MODE>
__device__ __forceinline__ void chunk64(const LAS char* kt, const LAS char* vt, const bf16x8 (&qf)[2], St& st, int lane, int pa, int pb) {
    const int mrow = lane & 15, g = lane >> 4;
    f32x4 s[4];
#pragma unroll
    for (int b = 0; b < 4; ++b) {
        const int krow = 32 * (b >> 1) + 8 * (mrow >> 2) + 4 * (b & 1) + (mrow & 3);
        const LAS char* kp = kt + krow * PITCH + 16 * g;
        const bf16x8 a0 = *(const LAS bf16x8*)kp, a1 = *(const LAS bf16x8*)(kp + 64);
        f32x4 z = (f32x4){0.f, 0.f, 0.f, 0.f};
        z = __builtin_amdgcn_mfma_f32_16x16x32_bf16(a0, qf[0], z, 0, 0, 0);
        z = __builtin_amdgcn_mfma_f32_16x16x32_bf16(a1, qf[1], z, 0, 0, 0);
        s[b] = z;
    }
    float p[16];
    const unsigned t0 = MODE == 2 ? (unsigned)(pa + 8 * g) : 0u, span = MODE == 2 ? (unsigned)pb : 0u;
#pragma unroll
    for (int b = 0; b < 4; ++b)
#pragma unroll
        for (int i = 0; i < 4; ++i) {
            float v = s[b][i];
            if (MODE == 2) v = (t0 + (unsigned)(32 * (b >> 1) + 4 * (b & 1) + i)) <= span ? v : -1e30f;
            p[4 * b + i] = v;
        }
    float mx = fmax2(fmax2(fmax2(fmax2(p[0], p[1]), fmax2(p[2], p[3])), fmax2(fmax2(p[4], p[5]), fmax2(p[6], p[7]))),
                     fmax2(fmax2(fmax2(p[8], p[9]), fmax2(p[10], p[11])), fmax2(fmax2(p[12], p[13]), fmax2(p[14], p[15]))));
    mx = xmax32(xmax16(mx));
    const float mn = fmax2(st.m, mx);
    const float alpha = fexp2(st.m - mn);
    float rs0 = 0.f, rs1 = 0.f;
#pragma unroll
    for (int k = 0; k < 8; ++k) { const float e0 = fexp2(p[k] - mn), e1 = fexp2(p[8 + k] - mn); p[k] = e0; p[8 + k] = e1; rs0 += e0; rs1 += e1; }
    st.l = st.l * alpha + (rs0 + rs1); st.m = mn;
#pragma unroll
    for (int d = 0; d < 4; ++d) st.o[d] = st.o[d] * alpha;
#pragma unroll
    for (int hh = 0; hh < 2; ++hh) {
        u32x4 pw; pw.x = cvt_pk_bf16(p[8 * hh], p[8 * hh + 1]); pw.y = cvt_pk_bf16(p[8 * hh + 2], p[8 * hh + 3]); pw.z = cvt_pk_bf16(p[8 * hh + 4], p[8 * hh + 5]); pw.w = cvt_pk_bf16(p[8 * hh + 6], p[8 * hh + 7]);
        const bf16x8 pbv = __builtin_bit_cast(bf16x8, pw);
        const LAS char* vp = vt + (32 * hh + 8 * g + (mrow >> 2)) * PITCH + (mrow & 3) * 8;
#pragma unroll
        for (int d = 0; d < 4; ++d) {
            const s16x4 lo = vtr(vp + d * 32), hi = vtr(vp + d * 32 + 4 * PITCH);
            const bf16x8 af = (bf16x8){lo[0], lo[1], lo[2], lo[3], hi[0], hi[1], hi[2], hi[3]};
            st.o[d] = __builtin_amdgcn_mfma_f32_16x16x32_bf16(af, pbv, st.o[d], 0, 0, 0);
        }
    }
}
__device__ __forceinline__ void finish(St& st, bf16_t* dst  , int lane) {
    const int g = lane >> 4;
    const float lt = xadd32(xadd16(st.l));
    const float inv = 1.0f / lt;
#pragma unroll
    for (int d = 0; d < 4; ++d) { const f32x4 v = st.o[d] * inv; u32x2 w; w.x = cvt_pk_bf16(v[0], v[1]); w.y = cvt_pk_bf16(v[2], v[3]); *(u32x2*)(dst + 16 * d + 4 * g) = w; }
}

__device__ __forceinline__ void na_unit(const bf16_t* __restrict__ P, bf16_t* __restrict__ CAT, const float* __restrict__ rpb, LAS char* lds, int b, int hp, int r, int cq) {
    const int tid = opaque_tid(), lane = tid & 63, w = __builtin_amdgcn_readfirstlane(tid >> 6), half = w >> 2, jb = w & 3, ht = tid & 255, h = 2 * hp + half;
    LAS char* hb = lds + half * (2 * BUF);
    LAS float* rp = (LAS float*)(lds + 4 * BUF) + half * 512;
    const bool ctxq = r < 0;
    if (!ctxq) { const float r0 = rpb[h * 465 + ht], r1 = ht + 256 < 465 ? rpb[h * 465 + ht + 256] : 0.f; rp[ht] = r0 * LOG2E; if (ht + 256 < 465) rp[ht + 256] = r1 * LOG2E; }
    const int rowb = b * RPB, mrow = lane & 15, g = lane >> 4;
    const int m0 = ctxq ? rowb + cq * 64 + 16 * jb : rowb + CTXL + r * 64 + 16 * jb;
    bf16x8 qf[2]; { const bf16_t* qp = P + (size_t)(m0 + mrow) * DIN + C_QA + h * 64 + 8 * g; qf[0] = *(const bf16x8*)qp; qf[1] = *(const bf16x8*)(qp + 32); }
    int r0 = r - 4; r0 = r0 < 0 ? 0 : (r0 > GRH - 8 ? GRH - 8 : r0);
    const int NS = ctxq ? 4 : 12;
    int bidx[8]; bool bok[8];
    { const int qc = 16 * jb + mrow, wsc = jb == 0 ? 0 : (jb == 1 ? 8 : (jb == 2 ? 24 : 32)); int c0 = qc - 8; c0 = c0 < 0 ? 0 : (c0 > 48 ? 48 : c0);
#pragma unroll
      for (int k = 0; k < 8; ++k) { const int kc = wsc + 8 * g + k; bok[k] = (kc >= c0) && (kc < c0 + 16); int idx = kc - qc + 15; bidx[k] = idx < 0 ? 0 : (idx > 30 ? 30 : idx); } }
    u32x4 rgA[4], rgB[4];
#define NA_LOAD(rg, s) do { const int base_ = (s) < 4 ? rowb + 64 * (s) : rowb + CTXL + (r0 + (s) - 4) * 64; _Pragma("unroll") for (int i_ = 0; i_ < 4; ++i_) { const int idx_ = (ht + 256 * i_) & 511; \
        rg[i_] = *(const u32x4*)(P + (size_t)(base_ + (idx_ >> 3)) * DIN + (i_ < 2 ? C_KA : C_VA) + h * 64 + (idx_ & 7) * 8); } } while (0)
#define NA_STORE(rg, bf) do { _Pragma("unroll") for (int i_ = 0; i_ < 4; ++i_) { const int idx_ = (ht + 256 * i_) & 511; \
        *(LAS u32x4*)(hb + (bf) * BUF + (i_ < 2 ? 0 : TILE) + (idx_ >> 3) * PITCH + (idx_ & 7) * 16) = rg[i_]; } } while (0)
#define NA_STEP(s, bf) do { const LAS char* kt = hb + (bf) * BUF; const LAS char* vt = kt + TILE; \
        if ((s) < 4) { chunk64<0>(kt, vt, qf, st, lane, 0, 0); } \
        else { const int kr = r0 + (s) - 4, ws = jb == 0 ? 0 : (jb == 1 ? 8 : (jb == 2 ? 24 : 32)), dr = kr - r + 7; \
            chunk<1>(kt + ws * PITCH, vt + ws * PITCH, qf, st, lane, 0, 0, rp + dr * 31, bidx, bok); } } while (0)
    St st; st.m = -1e30f; st.l = 0.f;
#pragma unroll
    for (int d = 0; d < 4; ++d) st.o[d] = (f32x4){0.f, 0.f, 0.f, 0.f};
    NA_LOAD(rgA, 0); NA_LOAD(rgB, 1); NA_STORE(rgA, 0); NA_STORE(rgB, 1); __syncthreads();
    asm volatile("" : "+v"(qf[0]), "+v"(qf[1]));
    for (int s = 0; s < NS; s += 2) {
        const bool more = s + 2 < NS;
        if (more) { NA_LOAD(rgA, s + 2); NA_LOAD(rgB, s + 3); }
        NA_STEP(s, 0); NA_STEP(s + 1, 1);
        __syncthreads();
        if (more) { NA_STORE(rgA, 0); NA_STORE(rgB, 1); __syncthreads(); }
    }
#undef NA_STEP
#undef NA_LOAD
#undef NA_STORE
    finish(st, CAT + (size_t)(m0 + mrow) * DM + h * 64, lane);
}

__device__ __forceinline__ void swa_unit(const bf16_t* __restrict__ P, bf16_t* __restrict__ CAT, const float* __restrict__ sink, LAS char* lds, int b, int kh, int qblk, int cq) {
    const int tid = opaque_tid(), lane = tid & 63, w = __builtin_amdgcn_readfirstlane(tid >> 6), gq = w >> 1, sb = w & 1, head = kh * 4 + gq;
    const bool ctxq = qblk < 0;
    const int rowb = b * RPB, mrow = lane & 15, g = lane >> 4;
    const int m0 = ctxq ? rowb + cq * 32 + 16 * sb : rowb + CTXL + qblk * 32 + 16 * sb;
    const int qw = qblk * 32 + 16 * sb, qpos = qw + mrow;
    bf16x8 qf[2]; { const bf16_t* qp = P + (size_t)(m0 + mrow) * DIN + C_QD + head * 64 + 8 * g; qf[0] = *(const bf16x8*)qp; qf[1] = *(const bf16x8*)(qp + 32); }
    const int NS = ctxq ? 4 : 9;
    const int bidx[8] = {0, 0, 0, 0, 0, 0, 0, 0}; const bool bok[8] = {true, true, true, true, true, true, true, true};
    int klo = qpos - 128; klo = klo < 0 ? 0 : klo; int khi = qpos + 128; khi = khi > SEQ - 1 ? SEQ - 1 : khi; const int kspan = khi - klo;
    u32x4 rgA[2], rgB[2];
    const int skey = tid >> 3, sch = tid & 7;
#define SW_LOAD(rg, s) do { int row_; if ((s) < 4) row_ = rowb + 64 * (s) + skey; else { int kp_ = qblk * 32 - 128 + 64 * ((s) - 4) + skey; kp_ = kp_ < 0 ? 0 : (kp_ > SEQ - 1 ? SEQ - 1 : kp_); row_ = rowb + CTXL + kp_; } \
        const bf16_t* src_ = P + (size_t)row_ * DIN + kh * 64 + sch * 8; rg[0] = *(const u32x4*)(src_ + C_KD); rg[1] = *(const u32x4*)(src_ + C_VD); } while (0)
#define SW_STORE(rg, bf) do { LAS char* d_ = lds + (bf) * BUF + skey * PITCH + sch * 16; *(LAS u32x4*)d_ = rg[0]; *(LAS u32x4*)(d_ + TILE) = rg[1]; } while (0)
#define SW_STEP(s, bf) do { const LAS char* kt = lds + (bf) * BUF; const LAS char* vt = kt + TILE; \
        if ((s) < 4) { chunk64<0>(kt, vt, qf, st, lane, 0, 0); } \
        else { const int kpa = qblk * 32 - 128 + 64 * ((s) - 4), kpb = kpa + 32; \
            const bool skipa = (kpa > qw + 15 + 128) || (kpa + 31 < qw - 128) || (kpa + 31 < 0) || (kpa >= SEQ), skipb = (kpb > qw + 15 + 128) || (kpb + 31 < qw - 128) || (kpb + 31 < 0) || (kpb >= SEQ); \
            if (!skipa && !skipb) chunk64<2>(kt, vt, qf, st, lane, kpa - klo, kspan); \
            else { if (!skipa) chunk<2>(kt, vt, qf, st, lane, kpa - klo, kspan, nullptr, bidx, bok); \
                   if (!skipb) chunk<2>(kt + 32 * PITCH, vt + 32 * PITCH, qf, st, lane, kpb - klo, kspan, nullptr, bidx, bok); } } } while (0)
    St st; st.m = sink[head] * LOG2E; st.l = (g == 0) ? 1.f : 0.f;
#pragma unroll
    for (int d = 0; d < 4; ++d) st.o[d] = (f32x4){0.f, 0.f, 0.f, 0.f};
    SW_LOAD(rgA, 0); SW_LOAD(rgB, 1); SW_STORE(rgA, 0); SW_STORE(rgB, 1); __syncthreads();
    asm volatile("" : "+v"(qf[0]), "+v"(qf[1]));
    for (int s = 0; s < NS; s += 2) {
        const bool more = s + 2 < NS, more2 = s + 3 < NS;
        if (more) SW_LOAD(rgA, s + 2);
        if (more2) SW_LOAD(rgB, s + 3);
        SW_STEP(s, 0);
        if (s + 1 < NS) SW_STEP(s + 1, 1);
        __syncthreads();
        if (more) { SW_STORE(rgA, 0); if (more2) SW_STORE(rgB, 1); __syncthreads(); }
    }
#undef SW_STEP
#undef SW_LOAD
#undef SW_STORE
    finish(st, CAT + (size_t)(m0 + mrow) * DM + 1536 + head * 64, lane);
}

__device__ __forceinline__ void unpack8(const u32x4 w, float (&f)[8]) { f[0] = bflo(w.x); f[1] = bfhi(w.x); f[2] = bflo(w.y); f[3] = bfhi(w.y); f[4] = bflo(w.z); f[5] = bfhi(w.z); f[6] = bflo(w.w); f[7] = bfhi(w.w); }
template <int GI>
__device__ __forceinline__ void pc_wave(const bf16_t* __restrict__ P, bf16_t* __restrict__ CAT, const float* __restrict__ convw, int m0, int chunk) {
    constexpr int HW = 1 << GI;
    const int ch0 = GI * 128 + chunk * 8;
    const int b = m0 / RPB, r = m0 - b * RPB; const bool isctx = r < CTXL;
    const int t0 = isctx ? r : r - CTXL, n = isctx ? CTXL : SEQ;
    const bf16_t* row0 = P + (size_t)m0 * DIN;
    float w0[8], w1[8], w2[8];
#pragma unroll
    for (int k = 0; k < 8; ++k) { w0[k] = convw[ch0 + k]; w1[k] = convw[512 + ch0 + k]; w2[k] = convw[1024 + ch0 + k]; }
    float up[8], uc[8], S[8], a[8], c[8];
#pragma unroll
    for (int q = 0; q < 8; ++q) { up[q] = 0.f; S[q] = 0.f; }
    if (t0 > 0) { unpack8(*(const u32x4*)(row0 - DIN + C_GC + ch0), a); unpack8(*(const u32x4*)(row0 - DIN + C_XV + ch0), c);
#pragma unroll
        for (int q = 0; q < 8; ++q) up[q] = a[q] * c[q]; }
    { unpack8(*(const u32x4*)(row0 + C_GC + ch0), a); unpack8(*(const u32x4*)(row0 + C_XV + ch0), c);
#pragma unroll
      for (int q = 0; q < 8; ++q) uc[q] = a[q] * c[q]; }
#pragma unroll
    for (int d = -HW; d < HW; ++d) { const int j = t0 + d; if (j >= 0 && j < n) { unpack8(*(const u32x4*)(row0 + (ptrdiff_t)d * DIN + C_UB + ch0), a);
#pragma unroll
        for (int q = 0; q < 8; ++q) S[q] += a[q]; } }
    for (int k = 0; k < 8; ++k) {
        const int t = t0 + k; const bf16_t* row = row0 + (size_t)k * DIN;
        const bool hn = t + 1 < n, hp = t + HW < n, hm = t - HW >= 0;
        float un[8], gbv[8], ubt[8], ua[8], us[8];
        const u32x4 z = (u32x4){0u, 0u, 0u, 0u};
        const u32x4 l0 = hn ? *(const u32x4*)(row + DIN + C_GC + ch0) : z, l1 = hn ? *(const u32x4*)(row + DIN + C_XV + ch0) : z, l2 = *(const u32x4*)(row + C_GB + ch0),
                    l3 = *(const u32x4*)(row + C_UB + ch0), l4 = hp ? *(const u32x4*)(row + (ptrdiff_t)HW * DIN + C_UB + ch0) : z, l5 = hm ? *(const u32x4*)(row - (ptrdiff_t)HW * DIN + C_UB + ch0) : z;
        unpack8(l0, a); unpack8(l1, c);
#pragma unroll
        for (int q = 0; q < 8; ++q) un[q] = a[q] * c[q];
        unpack8(l2, gbv); unpack8(l3, ubt); unpack8(l4, ua); unpack8(l5, us);
        float y[8];
#pragma unroll
        for (int q = 0; q < 8; ++q) y[q] = gbv[q] * (w0[q] * up[q] + w1[q] * uc[q] + w2[q] * un[q]);
        u32x4 oc; oc.x = pk2(y[0], y[1]); oc.y = pk2(y[2], y[3]); oc.z = pk2(y[4], y[5]); oc.w = pk2(y[6], y[7]);
        const int m = m0 + k;
        *(u32x4*)(CAT + (size_t)m * DM + 1024 + ch0) = oc;
        int lo = t - HW; lo = lo < 0 ? 0 : lo; int hi = t + HW; hi = hi > n ? n : hi;
        const float ic = 1.0f / (float)(hi - lo);
        u32x4 ob; ob.x = pk2(S[0] * ic - ubt[0], S[1] * ic - ubt[1]); ob.y = pk2(S[2] * ic - ubt[2], S[3] * ic - ubt[3]); ob.z = pk2(S[4] * ic - ubt[4], S[5] * ic - ubt[5]); ob.w = pk2(S[6] * ic - ubt[6], S[7] * ic - ubt[7]);
        *(u32x4*)(CAT + (size_t)m * DM + 512 + ch0) = ob;
#pragma unroll
        for (int q = 0; q < 8; ++q) { S[q] += ua[q] - us[q]; up[q] = uc[q]; uc[q] = un[q]; }
    }
}
__device__ __forceinline__ void pc_unit(const bf16_t* __restrict__ P, bf16_t* __restrict__ CAT, const float* __restrict__ convw, int unit) {
    const int tid = opaque_tid(), lane = tid & 63, w = __builtin_amdgcn_readfirstlane(tid >> 6), gi = w & 3;
    const int m0 = unit * 64 + (w >> 2) * 32 + (lane >> 4) * 8, chunk = lane & 15;
    if (gi == 0) pc_wave<0>(P, CAT, convw, m0, chunk); else if (gi == 1) pc_wave<1>(P, CAT, convw, m0, chunk); else if (gi == 2) pc_wave<2>(P, CAT, convw, m0, chunk); else pc_wave<3>(P, CAT, convw, m0, chunk);
}
}
#define XB_TMO      128
#define XB_XCNT(j)  (256  + 64 * (j))
#define XB_XSUB(j)  (1280 + 64 * (j))
#define XB_XGEN(j)  (2304 + 64 * (j))
#define XB_TOP      3328
#define XB_TOPGEN   3392
#define XCD_BAR_WORDS 3456
#define XB_SPIN_CAP (1u << 18)

__device__ __forceinline__ unsigned xb_ld(unsigned* p)              { return __hip_atomic_load(p, __ATOMIC_RELAXED, __HIP_MEMORY_SCOPE_AGENT); }
__device__ __forceinline__ unsigned xb_add(unsigned* p, unsigned v) { return __hip_atomic_fetch_add(p, v, __ATOMIC_RELAXED, __HIP_MEMORY_SCOPE_AGENT); }
__device__ __forceinline__ unsigned xb_xcc_id() { return (unsigned)__builtin_amdgcn_s_getreg((3 << 11) | 20) & 0xFu; }
#define XB_SPIN(cond, bar) do { unsigned _sp = 0; while (cond) { __builtin_amdgcn_s_sleep(1); \
    if ((++_sp & 255u) == 0u) { if (xb_ld(&(bar)[XB_TMO])) break; if (_sp > XB_SPIN_CAP) { atomicAdd(&(bar)[XB_TMO], 1u); break; } } } } while (0)

struct XcdBarrier {
    unsigned* bar; unsigned x;
    volatile LAS unsigned* st;
};

__device__ __forceinline__ XcdBarrier xcd_barrier_post(unsigned* bar, volatile LAS unsigned* st) {
    XcdBarrier b; b.bar = bar; b.x = xb_xcc_id(); b.st = st;
    if (threadIdx.x == 0) (void)xb_add(&bar[XB_XCNT(b.x)], 1u);
    return b;
}
__device__ __forceinline__ void xcd_barrier_complete(unsigned* bar, unsigned x, unsigned& nloc, unsigned& nx) {
    const unsigned G = gridDim.x * gridDim.y * gridDim.z;
    unsigned sum, cnt, mine, sp = 0u;
    for (;;) {
        sum = 0u; cnt = 0u; mine = 0u;
#pragma unroll
        for (unsigned j = 0; j < 16; ++j) { const unsigned c = xb_ld(&bar[XB_XCNT(j)]); sum += c; cnt += (c > 0u) ? 1u : 0u; mine = (j == x) ? c : mine; }
        if (sum == G) break;
        __builtin_amdgcn_s_sleep(1);
        if ((++sp & 255u) == 0u) { if (xb_ld(&bar[XB_TMO])) break; if (sp > XB_SPIN_CAP) { atomicAdd(&bar[XB_TMO], 1u); break; } }
    }
    nloc = mine > 0u ? mine : 1u; nx = cnt > 0u ? cnt : 1u;
}

__device__ __forceinline__ void xcd_barrier(const XcdBarrier& b) {
    asm volatile("s_waitcnt vmcnt(0)" ::: "memory");
    __syncthreads();
    if (threadIdx.x == 0) {
        unsigned* bar = b.bar;
        __builtin_amdgcn_s_waitcnt(0);
        unsigned nloc = b.st[0], nx = b.st[1];
        if (nloc == 0u) { xcd_barrier_complete(bar, b.x, nloc, nx); b.st[0] = nloc; b.st[1] = nx; }
        const unsigned old = xb_add(&bar[XB_XSUB(b.x)], 1u);
        const unsigned gen = old / nloc;
        if (old + 1u == (gen + 1u) * nloc) {
            __builtin_amdgcn_fence(__ATOMIC_RELEASE, "agent");
            asm volatile("s_waitcnt vmcnt(0)" ::: "memory");
            const unsigned og = xb_add(&bar[XB_TOP], 1u);
            const unsigned tg = og / nx;
            if (og + 1u == (tg + 1u) * nx) xb_add(&bar[XB_TOPGEN], 1u);
            else XB_SPIN(xb_ld(&bar[XB_TOPGEN]) == tg, bar);
            __builtin_amdgcn_fence(__ATOMIC_ACQUIRE, "agent");
            xb_add(&bar[XB_XGEN(b.x)], 1u);
            asm volatile("s_waitcnt vmcnt(0)" ::: "memory");
        } else {
            XB_SPIN(xb_ld(&bar[XB_XGEN(b.x)]) == gen, bar);
            __builtin_amdgcn_fence(__ATOMIC_ACQUIRE, "agent");
            asm volatile("s_waitcnt vmcnt(0)" ::: "memory");
        }
    }
    __syncthreads();
}
constexpr int RING_BYTES = 131072;
constexpr int MISC_OFF = RING_BYTES + 320;
constexpr int LDS_BYTES = 147456;
constexpr int NWAVES = 8;

struct Args { const float* in[23]; float* out; unsigned char* ws; int ph_lo, ph_hi; };
enum { I_X = 0, I_C, I_CTX, I_CCTX, I_WADA, I_BADA, I_NMIX, I_NFFN, I_NFIN, I_WIN, I_WOUT, I_RPB, I_POOLW, I_POOLS, I_CONVW, I_SINK, I_FG, I_FU, I_FD, I_ROUTER, I_MG, I_MU, I_MD };

template <bool BLK = false>
__device__ __forceinline__ void tr_item(const float* __restrict__ W, int ldw, int scol, int k0, bf16_t* __restrict__ WT, int ldk, int n0, LAS float* scr, int lane) {
    const float* src = W + (size_t)(k0 + (lane >> 5)) * ldw + scol;
    float tv[32];
#pragma unroll
    for (int i = 0; i < 32; ++i) tv[i] = __builtin_nontemporal_load(src + (size_t)(2 * i) * ldw);
#pragma unroll
    for (int i = 0; i < 32; ++i) { const int kk = 2 * i + (lane >> 5); scr[kk * 33 + (lane & 31)] = tv[i]; }
    asm volatile("s_waitcnt lgkmcnt(0)" ::: "memory");
    const int c = lane & 7;
#pragma unroll
    for (int j = 0; j < 4; ++j) { const int n = (lane >> 3) + 8 * j; const LAS float* s = scr + (8 * c) * 33 + n;
        u32x4 o; o.x = pk2(s[0 * 33], s[1 * 33]); o.y = pk2(s[2 * 33], s[3 * 33]); o.z = pk2(s[4 * 33], s[5 * 33]); o.w = pk2(s[6 * 33], s[7 * 33]);
        if (BLK) { const int nn = n0 + n; *(u32x4*)(WT + (size_t)(nn >> 8) * (256 * (size_t)ldk) + (size_t)(k0 >> 6) * (256 * 64) + (nn & 255) * 64 + 8 * c) = o; }
        else *(u32x4*)(WT + (size_t)(n0 + n) * ldk + k0 + 8 * c) = o; }
    asm volatile("s_waitcnt lgkmcnt(0)" ::: "memory");
}

__device__ __forceinline__ void tr_item8(const float* __restrict__ W, int ldw, int scol, int k0, unsigned char* __restrict__ WT, int ldk, int n0, float sc, LAS float* scr, int lane) {
    const float* src = W + (size_t)(k0 + (lane >> 5)) * ldw + scol;
    float tv[32];
#pragma unroll
    for (int i = 0; i < 32; ++i) tv[i] = __builtin_nontemporal_load(src + (size_t)(2 * i) * ldw);
#pragma unroll
    for (int i = 0; i < 32; ++i) { const int kk = 2 * i + (lane >> 5); scr[kk * 33 + (lane & 31)] = tv[i]; }
    asm volatile("s_waitcnt lgkmcnt(0)" ::: "memory");
    const int n = lane >> 1, hf = lane & 1; const LAS float* s = scr + (32 * hf) * 33 + n;
    u32x4 o0, o1;
    o0.x = pg8::pk_fp8x4(s[0 * 33] * sc, s[1 * 33] * sc, s[2 * 33] * sc, s[3 * 33] * sc); o0.y = pg8::pk_fp8x4(s[4 * 33] * sc, s[5 * 33] * sc, s[6 * 33] * sc, s[7 * 33] * sc);
    o0.z = pg8::pk_fp8x4(s[8 * 33] * sc, s[9 * 33] * sc, s[10 * 33] * sc, s[11 * 33] * sc); o0.w = pg8::pk_fp8x4(s[12 * 33] * sc, s[13 * 33] * sc, s[14 * 33] * sc, s[15 * 33] * sc);
    o1.x = pg8::pk_fp8x4(s[16 * 33] * sc, s[17 * 33] * sc, s[18 * 33] * sc, s[19 * 33] * sc); o1.y = pg8::pk_fp8x4(s[20 * 33] * sc, s[21 * 33] * sc, s[22 * 33] * sc, s[23 * 33] * sc);
    o1.z = pg8::pk_fp8x4(s[24 * 33] * sc, s[25 * 33] * sc, s[26 * 33] * sc, s[27 * 33] * sc); o1.w = pg8::pk_fp8x4(s[28 * 33] * sc, s[29 * 33] * sc, s[30 * 33] * sc, s[31 * 33] * sc);
    unsigned char* dst = WT + (size_t)(n0 + n) * ldk + k0 + 32 * hf;
    *(u32x4*)dst = o0; *(u32x4*)(dst + 16) = o1;
    asm volatile("s_waitcnt lgkmcnt(0)" ::: "memory");
}

__device__ __forceinline__ unsigned pk_i8x4(float a, float b, float c, float d) {
    const int ia = (int)__builtin_rintf(a), ib = (int)__builtin_rintf(b), ic = (int)__builtin_rintf(c), id = (int)__builtin_rintf(d);
    return (unsigned)(ia & 255) | ((unsigned)(ib & 255) << 8) | ((unsigned)(ic & 255) << 16) | ((unsigned)(id & 255) << 24); }
__device__ __forceinline__ void tr_item_i8(const float* __restrict__ W, int ldw, int scol, int k0, unsigned char* __restrict__ WT, int ldk, int n0, const unsigned* __restrict__ colmax, LAS float* scr, int lane) {
    const float* src = W + (size_t)(k0 + (lane >> 5)) * ldw + scol;
    float tv[32];
#pragma unroll
    for (int i = 0; i < 32; ++i) tv[i] = __builtin_nontemporal_load(src + (size_t)(2 * i) * ldw);
#pragma unroll
    for (int i = 0; i < 32; ++i) { const int kk = 2 * i + (lane >> 5); scr[kk * 33 + (lane & 31)] = tv[i]; }
    asm volatile("s_waitcnt lgkmcnt(0)" ::: "memory");
    const int n = lane >> 1, hf = lane & 1; const LAS float* s = scr + (32 * hf) * 33 + n;
    const float cm = __uint_as_float(colmax[n0 + n]); const float sc = cm > 0.f ? 127.0f / cm : 0.f;
    u32x4 o0, o1;
    o0.x = pk_i8x4(s[0 * 33] * sc, s[1 * 33] * sc, s[2 * 33] * sc, s[3 * 33] * sc); o0.y = pk_i8x4(s[4 * 33] * sc, s[5 * 33] * sc, s[6 * 33] * sc, s[7 * 33] * sc);
    o0.z = pk_i8x4(s[8 * 33] * sc, s[9 * 33] * sc, s[10 * 33] * sc, s[11 * 33] * sc); o0.w = pk_i8x4(s[12 * 33] * sc, s[13 * 33] * sc, s[14 * 33] * sc, s[15 * 33] * sc);
    o1.x = pk_i8x4(s[16 * 33] * sc, s[17 * 33] * sc, s[18 * 33] * sc, s[19 * 33] * sc); o1.y = pk_i8x4(s[20 * 33] * sc, s[21 * 33] * sc, s[22 * 33] * sc, s[23 * 33] * sc);
    o1.z = pk_i8x4(s[24 * 33] * sc, s[25 * 33] * sc, s[26 * 33] * sc, s[27 * 33] * sc); o1.w = pk_i8x4(s[28 * 33] * sc, s[29 * 33] * sc, s[30 * 33] * sc, s[31 * 33] * sc);
    unsigned char* dst = WT + (size_t)(n0 + n) * ldk + k0 + 32 * hf;
    *(u32x4*)dst = o0; *(u32x4*)(dst + 16) = o1;
    asm volatile("s_waitcnt lgkmcnt(0)" ::: "memory");
}
__device__ __forceinline__ void quant_dense_up(const Args& a, LAS unsigned char* lds, int G) {
    const int tid = opaque_tid(), lane = tid & 63, wave = __builtin_amdgcn_readfirstlane(tid >> 6), j = lane & 31;
    unsigned char* ws = a.ws; const unsigned* colmax = (const unsigned*)(ws + WS_CTL) + CW_COLMAX;
    LAS float* scr = (LAS float*)(lds + wave * 8448);
    const int gw = blockIdx.x * NWAVES + wave, NGW = G * NWAVES;
    for (int r = gw; r < 32 * 448; r += NGW) { const int kb = r / 448, nb = r % 448, n0 = nb * 32, tile = n0 >> 8, o = n0 & 255; const bool isup = o >= 128;
        tr_item_i8(isup ? a.in[I_FU] : a.in[I_FG], DFF, tile * 128 + (o & 127) + j, kb * 64, ws + WS_WGU, DM, n0, colmax, scr, lane); }
    float* colsc = (float*)(ws + WS_COLSC);
    for (int i = blockIdx.x * 512 + tid; i < NGU; i += G * 512) colsc[i] = __uint_as_float(colmax[i]) * (1.0f / 127.0f);
}

__device__ __forceinline__ void quant_w_in(const Args& a, LAS unsigned char* lds, int G, int l) {
    const int tid = opaque_tid(), lane = tid & 63, wave = __builtin_amdgcn_readfirstlane(tid >> 6), j = lane & 31;
    unsigned char* ws = a.ws; const unsigned* colmax = (const unsigned*)(ws + WS_CTL) + CW_COLMAX_IN + l * DIN;
    LAS float* scr = (LAS float*)(lds + wave * 8448);
    const int gw = blockIdx.x * NWAVES + wave, NGW = G * NWAVES;
    for (int r = gw; r < 32 * 136; r += NGW) { const int kb = r / 136, nb = r % 136, n0 = nb * 32; int col = n0 + j;
        if (n0 >= C_QD && n0 < C_VD) { const int hbn = col & ~63, o = col & 63, aa = o >> 3, i = o & 7; col = hbn + (i < 4 ? 4 * aa + i : 32 + 4 * aa + (i - 4)); }
        tr_item_i8(a.in[I_WIN] + (size_t)l * DM * DIN, DIN, col, kb * 64, ws + WS_WIN + (size_t)l * SZ_WIN, DM, n0, colmax, scr, lane); }
    float* colsc = (float*)(ws + WS_COLSC_IN) + l * DIN;
    for (int i = blockIdx.x * 512 + tid; i < DIN; i += G * 512) colsc[i] = __uint_as_float(colmax[i]) * (1.0f / 127.0f);
}

__constant__ double ROPE_C1[16] = {0.54030230586813977, 0.84600911028170789, 0.95041528025518285, 0.98423023447009461, 0.99500416527802582, 0.99841927779266448, 0.99950004166527784, 0.99984189028361437, 0.99995000041666526, 0.9999841886533658, 0.99999500000416663, 0.99999841886158658, 0.99999950000004167, 0.99999984188612112, 0.99999995000000041, 0.99999998418861169};
__constant__ double ROPE_S1[16] = {0.8414709848078965, 0.53316843991402285, 0.31098359290718575, 0.17689218624615005, 0.099833416646828155, 0.056204499214692491, 0.031617506402433708, 0.01778185687966613, 0.0099998333341666645, 0.0056233836139601857, 0.0031622723897082477, 0.0017782784728035289, 0.00099999983333334168, 0.00056234129555235944, 0.00031622776074637522, 0.00017782794006665674};

__device__ __forceinline__ void p0_prologue(const Args& a, LAS unsigned char* lds, int G) {
    const int tid = opaque_tid(), lane = tid & 63, wave = __builtin_amdgcn_readfirstlane(tid >> 6);
    unsigned char* ws = a.ws;
    {
        LAS float* sv = (LAS float*)lds; LAS float* red = (LAS float*)(lds + 24576);
        { float xs[12];
#pragma unroll
          for (int q = 0; q < 12; ++q) { const int v = q >> 2, k = (tid + 512 * q) & 2047; xs[q] = v < 2 ? a.in[I_C][v * DM + k] : a.in[I_CCTX][k]; }
#pragma unroll
          for (int q = 0; q < 12; ++q) sv[tid + 512 * q] = xs[q] / (1.0f + expf(-xs[q])); }
        __syncthreads();
        float* MOD = (float*)(ws + WS_MOD);
        for (int unit = blockIdx.x; unit < 512; unit += G) {
            const int l = unit >> 8, n0 = (unit & 255) * 48;
            if (tid < 384) {
                const int cg = tid % 12, ks = tid / 12;
                const float* wp = a.in[I_WADA] + ((size_t)l * DM + 64 * ks) * 12288 + n0 + 4 * cg;
                f32x4 acc[3]; acc[0] = acc[1] = acc[2] = (f32x4){0.f, 0.f, 0.f, 0.f};
#pragma unroll 32
                for (int kk = 0; kk < 64; ++kk) { const f32x4 w = *(const f32x4*)(wp + (size_t)kk * 12288); const int k = 64 * ks + kk;
                    acc[0] += w * sv[k]; acc[1] += w * sv[DM + k]; acc[2] += w * sv[2 * DM + k]; }
#pragma unroll
                for (int v = 0; v < 3; ++v) *(LAS f32x4*)(red + (ks * 12 + cg) * 12 + v * 4) = acc[v];
            }
            __syncthreads();
            if (tid < 144) { const int v = tid / 48, c = tid % 48, cg = c >> 2, ci = c & 3; float s = 0.f;
                for (int ks = 0; ks < 32; ++ks) s += red[(ks * 12 + cg) * 12 + v * 4 + ci];
                MOD[(size_t)(l * 3 + v) * 12288 + n0 + c] = s + a.in[I_BADA][l * 12288 + n0 + c]; }
            __syncthreads();
        }
    }
    { const int gt = blockIdx.x * 512 + tid;
      if (gt < 128 * 16) { const int pos = gt >> 4, f = gt & 15; double cr = 1.0, ci = 0.0, br = ROPE_C1[f], bi = ROPE_S1[f];
#pragma unroll
          for (int bit = 0; bit < 7; ++bit) { if ((pos >> bit) & 1) { const double t = cr * br - ci * bi; ci = cr * bi + ci * br; cr = t; } const double t2 = br * br - bi * bi; bi = 2.0 * br * bi; br = t2; }
          ((f32x2*)(ws + WS_ROPE))[gt] = (f32x2){(float)cr, (float)ci}; } }
    { LAS float* woL = (LAS float*)lds; LAS float* pwL = (LAS float*)(lds + 32768);
      for (int it = blockIdx.x; it < 256; it += G) {
        const int l = it >> 7, g = (it >> 5) & 3, nb = it & 31;
        const float* pw = a.in[I_POOLW] + (size_t)((l * 4 + g) * 128) * 128;
        const float* sc = a.in[I_POOLS] + l * 512 + g * 128;
        const float* wo = a.in[I_WOUT] + ((size_t)l * DM + 512 + g * 128) * DM + nb * 64;
        f32x4 wv[4], pv[8]; float sv[4];
#pragma unroll
        for (int i = 0; i < 4; ++i) { const int idx = tid + 512 * i; wv[i] = *(const f32x4*)(wo + (size_t)(idx >> 4) * DM + 4 * (idx & 15)); sv[i] = sc[idx >> 4]; }
#pragma unroll
        for (int i = 0; i < 8; ++i) pv[i] = *(const f32x4*)(pw + 4 * (tid + 512 * i));
#pragma unroll
        for (int i = 0; i < 4; ++i) *(LAS f32x4*)(woL + 4 * (tid + 512 * i)) = wv[i] * sv[i];
#pragma unroll
        for (int i = 0; i < 8; ++i) *(LAS f32x4*)(pwL + 4 * (tid + 512 * i)) = pv[i];
        __syncthreads();
        float acc[16];
#pragma unroll
        for (int c = 0; c < 16; ++c) acc[c] = 0.f;
        for (int d = 0; d < 128; d += 4) {
            const float w0 = woL[d * 64 + lane], w1 = woL[(d + 1) * 64 + lane], w2 = woL[(d + 2) * 64 + lane], w3 = woL[(d + 3) * 64 + lane];
#pragma unroll
            for (int c = 0; c < 16; ++c) { const f32x4 p = *(const LAS f32x4*)(pwL + (16 * wave + c) * 128 + d); acc[c] += (p[0] * w0 + p[1] * w1) + (p[2] * w2 + p[3] * w3); }
        }
        bf16_t* dst = (bf16_t*)(ws + WS_WOUT + (size_t)l * SZ_WOUT) + (size_t)(nb * 64 + lane) * DM + 512 + g * 128 + 16 * wave;
        u32x4 o0, o1; o0.x = pk2(acc[0], acc[1]); o0.y = pk2(acc[2], acc[3]); o0.z = pk2(acc[4], acc[5]); o0.w = pk2(acc[6], acc[7]);
        o1.x = pk2(acc[8], acc[9]); o1.y = pk2(acc[10], acc[11]); o1.z = pk2(acc[12], acc[13]); o1.w = pk2(acc[14], acc[15]);
        *(u32x4*)dst = o0; *(u32x4*)(dst + 8) = o1;
        __syncthreads();
      } }
    {
        LAS float* scr = (LAS float*)(lds + wave * 8448);
        const int gw = blockIdx.x * NWAVES + wave, NGW = G * NWAVES, j = lane & 31;
        constexpr int T0 = 2 * 32 * 136, T1 = 2 * 24 * 64, T2 = 32 * 448, T3 = 112 * 64;
        for (int it = gw; it < T0 + T1 + T2 + T3; it += NGW) {
            int r = it;
            if (r < T0) { const int l = r / 4352; r -= l * 4352; const int kb = r / 136, nb = r % 136, n0 = nb * 32; int col = n0 + j;
                if (n0 >= C_QD && n0 < C_VD) { const int hbn = col & ~63, o = col & 63, aa = o >> 3, i = o & 7; col = hbn + (i < 4 ? 4 * aa + i : 32 + 4 * aa + (i - 4)); }
                { const float* src = a.in[I_WIN] + (size_t)l * DM * DIN + (size_t)(kb * 64 + (lane >> 5)) * DIN + col; float mxv = 0.f;
#pragma unroll
                  for (int i = 0; i < 32; ++i) mxv = fmaxf(mxv, fabsf(__builtin_nontemporal_load(src + (size_t)(2 * i) * DIN)));
                  mxv = fmaxf(mxv, __shfl_xor(mxv, 32));
                  if (lane < 32) atomicMax((unsigned*)(ws + WS_CTL) + CW_COLMAX_IN + l * DIN + n0 + j, __float_as_uint(mxv)); }
                continue; }
            r -= T0;
            if (r < T1) { const int l = r / 1536; r -= l * 1536; int kb = r / 64; const int nb = r % 64; kb = kb < 8 ? kb : kb + 8;
                tr_item(a.in[I_WOUT] + (size_t)l * DM * DM, DM, nb * 32 + j, kb * 64, (bf16_t*)(ws + WS_WOUT + (size_t)l * SZ_WOUT), DM, nb * 32, scr, lane); continue; }
            r -= T1;
            if (r < T2) { const int kb = r / 448, nb = r % 448, n0 = nb * 32, tile = n0 >> 8, o = n0 & 255; const bool isup = o >= 128;
                const float* src = (isup ? a.in[I_FU] : a.in[I_FG]) + (size_t)(kb * 64 + (lane >> 5)) * DFF + tile * 128 + (o & 127) + j; float mxv = 0.f;
#pragma unroll
                for (int i = 0; i < 32; ++i) mxv = fmaxf(mxv, fabsf(__builtin_nontemporal_load(src + (size_t)(2 * i) * DFF)));
                mxv = fmaxf(mxv, __shfl_xor(mxv, 32));
                if (lane < 32) atomicMax((unsigned*)(ws + WS_CTL) + CW_COLMAX + n0 + j, __float_as_uint(mxv)); continue; }
            r -= T2;
            { const int kb = r / 64, nb = r % 64; tr_item<true>(a.in[I_FD], DM, nb * 32 + j, kb * 64, (bf16_t*)(ws + WS_WD), DFF, nb * 32, scr, lane); }
        }
    }
}

constexpr int CW_Q = 8192, CW_DONE = 8256;
constexpr int QI_UP = 8 * 32 * 448, QI_DN = 8 * 112 * 64, QGRABS = (QI_UP + QI_DN) / 8;
__device__ __forceinline__ void moe_conv_fill(const Args& a, LAS unsigned char* lds, int G, int done_word) {
    const int tid = opaque_tid(), lane = tid & 63, wave = __builtin_amdgcn_readfirstlane(tid >> 6), j = lane & 31;
    unsigned char* ws = a.ws; unsigned* ctl = (unsigned*)(ws + WS_CTL);
    LAS float* scr = (LAS float*)(lds + wave * 8448); volatile LAS int* shw = (volatile LAS int*)(lds + 8 * 8448);
    if (done_word >= 0 && tid == 0) __hip_atomic_fetch_add(ctl + done_word, 1u, RLX_AGENT);
    for (;;) {
        if (tid == 0) { int g = -1; const bool stop = done_word >= 0 && __hip_atomic_load(ctl + done_word, RLX_AGENT) >= (unsigned)G;
            if (!stop) { g = (int)__hip_atomic_fetch_add(ctl + CW_Q, 1u, RLX_AGENT); if (g >= QGRABS) g = -1; } shw[0] = g; }
        __syncthreads();
        const int g = shw[0];
        __syncthreads();
        if (g < 0) break;
        int r = g * 8 + wave;
        if (r < QI_UP) { const int e = r / 14336; r -= e * 14336; const int kb = r / 448, nb = r % 448, n0 = nb * 32, tile = n0 >> 8, o = n0 & 255; const bool isup = o >= 128;
            tr_item8((isup ? a.in[I_MU] : a.in[I_MG]) + (size_t)e * DM * DFF, DFF, tile * 128 + (o & 127) + j, kb * 64, ws + WS_WGU + SZ_WGU + (size_t)e * SZ_WGU8, DM, n0, WSC_UP, scr, lane); }
        else { r -= QI_UP; const int e = r / 7168; r -= e * 7168; const int kb = r / 64, nb = r % 64;
            tr_item8(a.in[I_MD] + (size_t)e * DFF * DM, DM, nb * 32 + j, kb * 64, ws + WS_WD + SZ_WD + (size_t)e * SZ_WD8, DFF, nb * 32, WSC_DN, scr, lane); }
    }
}

template <bool ROUTE, bool OUT_I8 = false>
__device__ __forceinline__ void norm_phase(const Args& a, LAS unsigned char* lds, int G, const float* gain, const float* mod, int shc, int scc, bool from_inputs, const float* router, const unsigned short* part, const float* pgate, int nparts, bool ctx_in) {
    const int tid = opaque_tid(), lane = tid & 63, wave = __builtin_amdgcn_readfirstlane(tid >> 6);
    unsigned char* ws = a.ws;
    LAS float* GT = (LAS float*)lds; LAS float* SH = GT + 3 * DM; LAS float* RT = SH + 3 * DM;
    LAS int* ES = (LAS int*)(RT + 8 * DM);
    for (int i = tid; i < 3 * DM; i += 512) { const int v = i >> 11, c = i & 2047; GT[i] = gain[c] * (1.0f + mod[v * 12288 + scc * DM + c]); SH[i] = mod[v * 12288 + shc * DM + c]; }
    if (ROUTE) for (int i = tid; i < 8 * DM; i += 512) { const int c = i >> 3, e = i & 7; RT[e * DM + c] = router[i]; }
    __syncthreads();
    const unsigned short* X = (const unsigned short*)(ws + WS_X); bf16_t* XN = (bf16_t*)(ws + WS_XN);
    const int ngroups = ROUTE ? NTOK / 64 : MROWS / 64;
    for (int grp = blockIdx.x; grp < ngroups; grp += G) {
        auto rowm = [&](int k) -> int { if (ROUTE) { const int tk = grp * 64 + wave * 8 + k; return (tk / SEQ) * RPB + CTXL + (tk % SEQ); } return grp * 64 + wave * 8 + k; };
        auto f32row = [&](int m) -> bool { const int b = m / RPB, r = m - b * RPB; return from_inputs || (!ROUTE && part != nullptr && r < CTXL && ctx_in); };
        auto proc = [&](f32x4 (&x)[8], const int m, const int k) {
            const int b = m / RPB, r = m - b * RPB, v = r < CTXL ? 2 : b;
            const bool cpart = !ROUTE && part != nullptr && r < CTXL;
            float ss = 0.f;
            if (cpart) {
#pragma unroll
                for (int j = 0; j < 8; ++j) { f32x4 sacc = (f32x4){0.f, 0.f, 0.f, 0.f}; const unsigned short* pp = part + (size_t)(b * 256 + r) * DM + 4 * lane + 256 * j;
                    for (int sI = 0; sI < nparts; ++sI) { const u32x2 pw_ = *(const u32x2*)(pp + (size_t)sI * 512 * DM); sacc += unpk_h4(pw_.x, pw_.y); }
                    x[j] += *(const f32x4*)(pgate + 4 * lane + 256 * j) * sacc;
                    if (ctx_in) { u32x2 wv; wv.x = pkh2(x[j][0], x[j][1]); wv.y = pkh2(x[j][2], x[j][3]); *(u32x2*)((unsigned short*)(ws + WS_X) + (size_t)m * DM + 4 * lane + 256 * j) = wv; } } }
#pragma unroll
            for (int j = 0; j < 8; ++j) ss += (x[j][0] * x[j][0] + x[j][1] * x[j][1]) + (x[j][2] * x[j][2] + x[j][3] * x[j][3]);
            const float rstd = 1.0f / sqrtf(wave_sum(ss) * (1.0f / DM) + EPS);
            float lg[8];
#pragma unroll
            for (int e = 0; e < 8; ++e) lg[e] = 0.f;
            float qs = 0.f;
            if (OUT_I8) {
                float am = 0.f;
#pragma unroll
                for (int j = 0; j < 8; ++j) { const int c = 4 * lane + 256 * j; const f32x4 gv = *(const LAS f32x4*)(GT + v * DM + c), sh = *(const LAS f32x4*)(SH + v * DM + c);
                    const f32x4 h = x[j] * rstd * gv + sh; am = fmaxf(am, fmaxf(fmaxf(fabsf(h[0]), fabsf(h[1])), fmaxf(fabsf(h[2]), fabsf(h[3])))); }
#pragma unroll
                for (int o = 1; o < 64; o <<= 1) am = fmaxf(am, __shfl_xor(am, o));
                qs = am > 0.f ? 127.0f / am : 0.f;
                if (lane == 0) ((float*)(ws + WS_ROWSC))[m] = am * (1.0f / 127.0f);
            }
#pragma unroll
            for (int j = 0; j < 8; ++j) { const int c = 4 * lane + 256 * j; const f32x4 gv = *(const LAS f32x4*)(GT + v * DM + c), sh = *(const LAS f32x4*)(SH + v * DM + c);
                const f32x4 h = x[j] * rstd * gv + sh;
                if (OUT_I8) { *(unsigned*)((unsigned char*)XN + (size_t)m * DM + c) = pk_i8x4(h[0] * qs, h[1] * qs, h[2] * qs, h[3] * qs); }
                else if (ROUTE) { *(unsigned*)((unsigned char*)XN + (size_t)m * DM + c) = pg8::pk_fp8x4(h[0], h[1], h[2], h[3]); }
                else { u32x2 w; w.x = pk2(h[0], h[1]); w.y = pk2(h[2], h[3]); *(u32x2*)(XN + (size_t)m * DM + c) = w; }
                if (ROUTE) {
#pragma unroll
                    for (int e = 0; e < 8; ++e) { const f32x4 rv = *(const LAS f32x4*)(RT + e * DM + c); lg[e] += (h[0] * rv[0] + h[1] * rv[1]) + (h[2] * rv[2] + h[3] * rv[3]); } } }
            if (ROUTE) {
#pragma unroll
                for (int e = 0; e < 8; ++e) lg[e] = wave_sum(lg[e]);
                int e0 = 0; float v0 = lg[0];
#pragma unroll
                for (int e = 1; e < 8; ++e) if (lg[e] > v0) { v0 = lg[e]; e0 = e; }
                int e1 = -1; float v1 = -3.0e38f;
#pragma unroll
                for (int e = 0; e < 8; ++e) if (e != e0 && lg[e] > v1) { v1 = lg[e]; e1 = e; }
                const float p1 = 1.0f / (1.0f + expf(v0 - v1)), p0 = 1.0f - p1;
                if (lane == 0) { const int tk = grp * 64 + wave * 8 + k; ES[(wave * 8 + k) * 2] = e0; ES[(wave * 8 + k) * 2 + 1] = e1;
                    ((f32x2*)(ws + WS_ROUTE + 262144))[tk] = (f32x2){p0, p1}; }
            }
                };
        if (from_inputs) {
            for (int k = 0; k < 8; ++k) { const int m = rowm(k); const float* src = in_row(a.in[I_X], a.in[I_CTX], m); f32x4 x[8];
#pragma unroll
                for (int j = 0; j < 8; ++j) x[j] = *(const f32x4*)(src + 4 * lane + 256 * j);
                proc(x, m, k); }
        } else {
            for (int k = 0; k < 8; k += 2) { const int m0 = rowm(k), m1 = rowm(k + 1); const bool q0 = f32row(m0), q1 = f32row(m1);
                f32x4 x0[8], x1[8]; u32x2 w0[8], w1[8];
                if (q0) { const float* src = in_row(a.in[I_X], a.in[I_CTX], m0);
#pragma unroll
                    for (int j = 0; j < 8; ++j) x0[j] = *(const f32x4*)(src + 4 * lane + 256 * j); }
                else { const unsigned short* src = X + (size_t)m0 * DM;
#pragma unroll
                    for (int j = 0; j < 8; ++j) w0[j] = *(const u32x2*)(src + 4 * lane + 256 * j); }
                if (q1) { const float* src = in_row(a.in[I_X], a.in[I_CTX], m1);
#pragma unroll
                    for (int j = 0; j < 8; ++j) x1[j] = *(const f32x4*)(src + 4 * lane + 256 * j); }
                else { const unsigned short* src = X + (size_t)m1 * DM;
#pragma unroll
                    for (int j = 0; j < 8; ++j) w1[j] = *(const u32x2*)(src + 4 * lane + 256 * j); }
                if (!q0) {
#pragma unroll
                    for (int j = 0; j < 8; ++j) x0[j] = unpk_h4(w0[j].x, w0[j].y); }
                proc(x0, m0, k);
                if (!q1) {
#pragma unroll
                    for (int j = 0; j < 8; ++j) x1[j] = unpk_h4(w1[j].x, w1[j].y); }
                proc(x1, m1, k + 1); }
        }
        if (ROUTE) {
            __syncthreads();
            if (wave == 0) { const int e0 = ES[lane * 2], e1 = ES[lane * 2 + 1]; int lr0 = 0, lr1 = 0; int mycnt = 0;
#pragma unroll
                for (int e = 0; e < 8; ++e) { const unsigned long long mk = __ballot(e0 == e || e1 == e); const int below = __popcll(mk & ((1ull << lane) - 1ull));
                    if (e0 == e) lr0 = below; if (e1 == e) lr1 = below; if (lane == e) mycnt = __popcll(mk); }
                ((int4*)(ws + WS_ROUTE))[grp * 64 + lane] = make_int4(e0, e1, lr0, lr1);
                if (lane < 8) ((int*)(ws + WS_CNT))[grp * 8 + lane] = mycnt; }
            __syncthreads();
        }
    }
}

__device__ __forceinline__ void slot_phase(const Args& a, LAS unsigned char* lds, int G) {
    const int tid = opaque_tid(), lane = tid & 63;
    unsigned char* ws = a.ws;
    LAS int* C = (LAS int*)lds; LAS int* TOT = C + 2048; LAS int* BASE = TOT + 8; LAS int* P = BASE + 8;
    const int* CNT = (const int*)(ws + WS_CNT);
    for (int i = tid; i < 2048; i += 512) C[i] = CNT[i];
    __syncthreads();
    { const int e = __builtin_amdgcn_readfirstlane(tid >> 6);
      const int v0 = C[(4 * lane) * 8 + e], v1 = C[(4 * lane + 1) * 8 + e], v2 = C[(4 * lane + 2) * 8 + e], v3 = C[(4 * lane + 3) * 8 + e];
      const int s = (v0 + v1) + (v2 + v3); int sc = s;
#pragma unroll
      for (int o = 1; o < 64; o <<= 1) { const int t = __shfl_up(sc, o); if (lane >= o) sc += t; }
      const int ex = sc - s;
      P[(4 * lane) * 8 + e] = ex; P[(4 * lane + 1) * 8 + e] = ex + v0; P[(4 * lane + 2) * 8 + e] = ex + v0 + v1; P[(4 * lane + 3) * 8 + e] = ex + v0 + v1 + v2;
      if (lane == 63) TOT[e] = sc; }
    __syncthreads();
    if (tid == 0) { int ts = 0; for (int e = 0; e < 8; ++e) { BASE[e] = ts * 256; if (blockIdx.x == 0) ((int*)(ws + WS_TILES))[1 + e] = ts; ts += (TOT[e] + 255) >> 8; } if (blockIdx.x == 0) ((int*)(ws + WS_TILES))[0] = ts; }
    __syncthreads();
    int* ROWTOK = (int*)(ws + WS_ROWTOK); int* ROWDST = (int*)(ws + WS_ROWDST); float* ROWP = (float*)(ws + WS_ROWP);
    for (int grp = blockIdx.x; grp < NTOK / 64; grp += G) {
        if (tid < 64) { const int tk = grp * 64 + lane; const int4 rt = ((const int4*)(ws + WS_ROUTE))[tk]; const f32x2 pp = ((const f32x2*)(ws + WS_ROUTE + 262144))[tk];
            const int m = (tk / SEQ) * RPB + CTXL + (tk % SEQ);
            const int s0 = BASE[rt.x] + P[grp * 8 + rt.x] + rt.z, s1 = BASE[rt.y] + P[grp * 8 + rt.y] + rt.w;
            ROWTOK[s0] = m; ROWDST[s0] = 2 * tk; ROWP[s0] = pp[0];
            ROWTOK[s1] = m; ROWDST[s1] = 2 * tk + 1; ROWP[s1] = pp[1];
            ((int*)(ws + WS_TAILF))[tk] = (s0 >= 128 * 256 || s1 >= 128 * 256) ? 1 : 0; ((int*)(ws + WS_SLOTS))[2 * tk] = s0; ((int*)(ws + WS_SLOTS))[2 * tk + 1] = s1; }
    }
    { const int e = blockIdx.x & 7; const int lo = BASE[e] + TOT[e], hi = BASE[e] + (((TOT[e] + 255) >> 8) << 8);
      for (int s = lo + (blockIdx.x >> 3) * 512 + tid; s < hi; s += ((G + 7) >> 3) * 512) { ROWTOK[s] = CTXL; ROWDST[s] = -1; ROWP[s] = 0.f; } }
}

__device__ __forceinline__ void final_phase(const Args& a, int nwg, int wgi, int tailmode) {
    const int tid = opaque_tid(), lane = tid & 63, wave = __builtin_amdgcn_readfirstlane(tid >> 6);
    unsigned char* ws = a.ws;
    const unsigned short* X = (const unsigned short*)(ws + WS_X); const bf16_t* FP = (const bf16_t*)(ws + WS_FP); const bf16_t* FP2 = (const bf16_t*)(ws + WS_FP2);
    const float* mod1 = (const float*)(ws + WS_MOD) + 3 * 12288;
    const float* gf = a.in[I_NFIN];
    const int* tailf = (const int*)(ws + WS_TAILF);
    const int tk0 = wgi * NWAVES + wave, tstep = nwg * NWAVES;
    for (int base = tk0; base < NTOK; base += 64 * tstep) {
      const int tkl = base + lane * tstep;
      unsigned long long todo = __ballot(tkl < NTOK && tailf[tkl] == tailmode);
      while (todo) {
        const int jb = __builtin_ctzll(todo); todo &= todo - 1;
        const int tk = base + jb * tstep;
        const int b = tk / SEQ, m = b * RPB + CTXL + (tk % SEQ);
        const float* g2 = mod1 + b * 12288 + 5 * DM;
        int sl0 = 0, sl1 = 0; if (tailmode) { sl0 = ((const int*)(ws + WS_SLOTS))[2 * tk]; sl1 = ((const int*)(ws + WS_SLOTS))[2 * tk + 1]; }
        f32x4 x[8]; float ss = 0.f;
#pragma unroll
        for (int j = 0; j < 8; ++j) { const int c = 4 * lane + 256 * j; const u32x2 xw = *(const u32x2*)(X + (size_t)m * DM + c); const f32x4 xv = unpk_h4(xw.x, xw.y), gv = *(const f32x4*)(g2 + c);
            const u32x2 f0 = *(const u32x2*)(FP + (size_t)(2 * tk) * DM + c), f1 = *(const u32x2*)(FP + (size_t)(2 * tk + 1) * DM + c);
            f32x4 f; f[0] = bflo(f0.x) + bflo(f1.x); f[1] = bfhi(f0.x) + bfhi(f1.x); f[2] = bflo(f0.y) + bflo(f1.y); f[3] = bfhi(f0.y) + bfhi(f1.y);
            if (tailmode) {
                if (sl0 >= 128 * 256) { const u32x2 g0 = *(const u32x2*)(FP2 + (size_t)(sl0 - 128 * 256) * DM + c); f[0] += bflo(g0.x); f[1] += bfhi(g0.x); f[2] += bflo(g0.y); f[3] += bfhi(g0.y); }
                if (sl1 >= 128 * 256) { const u32x2 g1 = *(const u32x2*)(FP2 + (size_t)(sl1 - 128 * 256) * DM + c); f[0] += bflo(g1.x); f[1] += bfhi(g1.x); f[2] += bflo(g1.y); f[3] += bfhi(g1.y); } }
            x[j] = xv + gv * f; ss += (x[j][0] * x[j][0] + x[j][1] * x[j][1]) + (x[j][2] * x[j][2] + x[j][3] * x[j][3]); }
        const float rstd = 1.0f / sqrtf(wave_sum(ss) * (1.0f / DM) + EPS);
#pragma unroll
        for (int j = 0; j < 8; ++j) { const int c = 4 * lane + 256 * j; const f32x4 gv = *(const f32x4*)(gf + c); *(f32x4*)(a.out + (size_t)tk * DM + c) = x[j] * rstd * gv; }
      }
    }
}
constexpr int N_PHASES = 18;
#ifndef MK_PER_PHASE
#define MK_PER_PHASE 0
#endif

__global__ void __launch_bounds__(NWAVES * 64, 2) mk_fwd(Args a) {
    extern __shared__ __attribute__((aligned(16))) unsigned char lds_raw[];
    LAS unsigned char* lds = (LAS unsigned char*)lds_raw;
    volatile LAS unsigned* MISC = (volatile LAS unsigned*)(lds + MISC_OFF);
    const int tid = threadIdx.x, G = gridDim.x;
    unsigned char* ws = a.ws;
    for (int u = tid; u < (LDS_BYTES - RING_BYTES) / 4; u += NWAVES * 64) ((LAS unsigned*)(lds + RING_BYTES))[u] = 0u;
    __syncthreads();
    const int lo = a.ph_lo, hi = a.ph_hi;
    XcdBarrier bar; bar.bar = (unsigned*)(ws + WS_CTL) + CW_BAR; bar.x = 0; bar.st = nullptr;
    if (hi - lo > 1) bar = xcd_barrier_post((unsigned*)(ws + WS_CTL) + CW_BAR, MISC + 8);
#define IN(k) (lo <= (k) && (k) < hi)
#define PHASE_REP(k) for (int rep_ = 0; rep_ < 1; ++rep_)
#define GRIDBAR() do { XcdBarrier b_ = bar; asm volatile("" : "+s"(b_.bar)); xcd_barrier(b_); } while (0)
#define SEAM(k) do { if ((k) + 1 < hi) { XcdBarrier b_ = bar; asm volatile("" : "+s"(b_.bar)); xcd_barrier(b_); } } while (0)
    float* MOD = (float*)(ws + WS_MOD);
    unsigned short* X = (unsigned short*)(ws + WS_X); bf16_t* XN = (bf16_t*)(ws + WS_XN); bf16_t* PROJ = (bf16_t*)(ws + WS_PROJ); bf16_t* CAT = (bf16_t*)(ws + WS_CAT);
    bf16_t* HID = (bf16_t*)(ws + WS_HID); bf16_t* FP = (bf16_t*)(ws + WS_FP);

    if (IN(0)) { PHASE_REP(0) { p0_prologue(a, lds, G); __syncthreads(); moe_conv_fill(a, lds, G, -1); } SEAM(0); }

    { constexpr int l = 0;
        const int pb = 1 + 8 * l;
        const float* modl = MOD + (size_t)l * 3 * 12288;
        if (IN(pb + 0)) { PHASE_REP(pb + 0) { norm_phase<false, true>(a, lds, G, a.in[I_NMIX] + l * DM, modl, 0, 1, l == 0, nullptr, l == 1 ? (const unsigned short*)(ws + WS_PART) : nullptr, MOD + 2 * 12288 + 5 * DM, 14, false); __syncthreads(); quant_w_in(a, lds, G, l); } SEAM(pb + 0); }
        if (IN(pb + 1)) { PHASE_REP(pb + 1) {
            pg8::Gemm g{XN, (const bf16_t*)(ws + WS_WIN + (size_t)l * SZ_WIN), DM / 2, 0, DM / 128};
            pg8::StaticOrder S; S.init(NPAN, DIN / 256, G, (int)blockIdx.x, 0);
            pg8::EpiProjI8 E{PROJ, (const f32x2*)(ws + WS_ROPE), (const float*)(ws + WS_ROWSC), (const float*)(ws + WS_COLSC_IN) + l * DIN};
            pg8::gemm_phase<pg8::EpiProjI8, pg8::StaticOrder, false, true>(lds, g, S, E, nullptr);
            } SEAM(pb + 1);
        }
        if (IN(pb + 2)) { PHASE_REP(pb + 2) {
            const float* sink = a.in[I_SINK] + l * 8; const float* rpb = a.in[I_RPB] + (size_t)l * 8 * 465; const float* convw = a.in[I_CONVW] + l * 3 * 512;
            { const bool sw = (G == 256); const int xcd = (int)blockIdx.x & 7, w = (int)blockIdx.x >> 3;
              for (int j = 0, i = blockIdx.x; i < 1024; ++j, i += G) { const int b_ = sw ? xcd >> 2 : i >> 9, kh_ = sw ? (xcd >> 1) & 1 : (i >> 8) & 1, q_ = sw ? (xcd & 1) * 128 + j * 32 + w : i & 255;
                  att::swa_unit(PROJ, CAT, sink, (LAS char*)lds, b_, kh_, q_, 0); }
              for (int j = 0, i = blockIdx.x; i < 1024; ++j, i += G) { const int b_ = sw ? xcd >> 2 : i >> 9, hp_ = sw ? xcd & 3 : (i >> 7) & 3, r_ = sw ? j * 32 + w : i & 127;
                  att::na_unit(PROJ, CAT, rpb, (LAS char*)lds, b_, hp_, r_, 0); } }
            if (l == 0) {
                for (int i = G - 1 - (int)blockIdx.x; i < 32; i += G) att::na_unit(PROJ, CAT, rpb, (LAS char*)lds, i >> 4, (i >> 2) & 3, -1, i & 3);
                for (int i = ((G - 33 - (int)blockIdx.x) % G + G) % G; i < 32; i += G) att::swa_unit(PROJ, CAT, sink, (LAS char*)lds, i >> 4, (i >> 3) & 1, -1, i & 7);
                for (int k = 0; k * G < MROWS / 64; ++k) { const int u = k * G + (((int)blockIdx.x - 64 * k) % G + G) % G; if (u < MROWS / 64) att::pc_unit(PROJ, CAT, convw, u); }
            } else {
                for (int i = blockIdx.x; i < NTOK / 64; i += G) att::pc_unit(PROJ, CAT, convw, (i >> 7) * 132 + 4 + (i & 127));
            }
            }
            SEAM(pb + 2);
        }
        if (IN(pb + 3)) { PHASE_REP(pb + 3) {
            pg8::Gemm g{CAT, (const bf16_t*)(ws + WS_WOUT + (size_t)l * SZ_WOUT), DM, 0, DM / 64};
            pg8::StaticOrder S; S.init(NPAN - 2, DM / 256, G, (int)blockIdx.x, 1);
            pg8::EpiResid E{X, a.in[I_X], a.in[I_CTX], modl + 2 * DM, l == 0 ? 1 : 0, rep_ ? (unsigned short*)(ws + WS_END) : X};
            pg8::gemm_phase<pg8::EpiResid, pg8::StaticOrder, false, true>(lds, g, S, E, nullptr);
            if (l == 0) {
                pg8::Gemm g2{CAT, (const bf16_t*)(ws + WS_WOUT), DM, 0, 8};
                pg8::CtxSplitOrder<4> S2{G, (int)blockIdx.x, 8 * 64 * 2};
                pg8::EpiPart E2{(unsigned short*)(ws + WS_PART)};
                pg8::gemm_phase<pg8::EpiPart, pg8::CtxSplitOrder<4>, false, true>(lds, g2, S2, E2, nullptr);
            }
            } SEAM(pb + 3);
        }
        if (l == 0) {
            if (IN(pb + 4)) { PHASE_REP(pb + 4) { norm_phase<false, true>(a, lds, G, a.in[I_NFFN], modl, 3, 4, false, nullptr, (const unsigned short*)(ws + WS_PART), MOD + 2 * 12288 + 2 * DM, 4, true); __syncthreads(); quant_dense_up(a, lds, G); } SEAM(pb + 4); }
            if (IN(pb + 6)) { PHASE_REP(pb + 6) {
                pg8::Gemm g{XN, (const bf16_t*)(ws + WS_WGU), DM / 2, 0, DM / 128};
                pg8::StaticOrder S; S.init(NPAN, NGU / 256, G, (int)blockIdx.x, 0);
                pg8::EpiSwigluI8 E{HID, (const float*)(ws + WS_ROWSC), (const float*)(ws + WS_COLSC)};
                pg8::gemm_phase<pg8::EpiSwigluI8, pg8::StaticOrder, false, true>(lds, g, S, E, nullptr);

                } SEAM(pb + 6);
            }
            if (IN(pb + 7)) { PHASE_REP(pb + 7) {
                pg8::Gemm g{HID, (const bf16_t*)(ws + WS_WD), DFF, 0, DFF / 64};
                pg8::StaticOrder S; S.init(NPAN - 2, DM / 256, G, (int)blockIdx.x, 1); S.wgm = 4;
                pg8::EpiResid E{X, a.in[I_X], a.in[I_CTX], modl + 5 * DM, 0, rep_ ? (unsigned short*)(ws + WS_END) : X};
                pg8::gemm_phase<pg8::EpiResid, pg8::StaticOrder, false, true, false, true>(lds, g, S, E, nullptr);
                pg8::Gemm g2{HID, (const bf16_t*)(ws + WS_WD), DFF, 0, 8};
                pg8::CtxSplitOrder<14> S2{G, (int)blockIdx.x, 8 * 256 * 64 * 2};
                pg8::EpiPart E2{(unsigned short*)(ws + WS_PART)};
                pg8::gemm_phase<pg8::EpiPart, pg8::CtxSplitOrder<14>, false, true, false, true>(lds, g2, S2, E2, nullptr);
                } SEAM(pb + 7);
            }
        } else {
            if (IN(pb + 4)) { PHASE_REP(pb + 4) { norm_phase<true>(a, lds, G, a.in[I_NFFN] + DM, modl, 3, 4, false, a.in[I_ROUTER], nullptr, nullptr, 0, false); } SEAM(pb + 4); }
            if (IN(pb + 5)) { slot_phase(a, lds, G); SEAM(pb + 5); }
            if (IN(pb + 6)) { PHASE_REP(pb + 6) {
                const int* TL = (const int*)(ws + WS_TILES);
                pg8::Gemm g{XN, (const bf16_t*)(ws + WS_WGU + SZ_WGU), DM / 2, SZ_WGU8, DM / 128};
                pg8::StaticOrder S; S.init(TL[0], NGU / 256, G, (int)blockIdx.x, 0);
#pragma unroll
                for (int e = 0; e < 8; ++e) S.ts[e] = TL[1 + e];
                pg8::EpiSwiglu8 E{(unsigned char*)HID, 1.0f / WSC_UP, HSC};
                pg8::gemm_phase<pg8::EpiSwiglu8, pg8::StaticOrder, true, true, true>(lds, g, S, E, (const int*)(ws + WS_ROWTOK));
                } SEAM(pb + 6);
            }
            if (IN(pb + 7)) { PHASE_REP(pb + 7) {
                const int* TL = (const int*)(ws + WS_TILES);
                pg8::Gemm g{HID, (const bf16_t*)(ws + WS_WD + SZ_WD), DFF / 2, SZ_WD8, DFF / 128};
                const int nmain = TL[0] < 128 ? TL[0] : 128, ntail = (TL[0] - nmain) * (DM / 256) * 2;
                pg8::StaticOrder S; S.init(nmain, DM / 256, G, (int)blockIdx.x, 0); S.wgm = 4;
#pragma unroll
                for (int e = 0; e < 8; ++e) S.ts[e] = TL[1 + e];
                pg8::EpiMoeDown E{FP, (const int*)(ws + WS_ROWDST), (const float*)(ws + WS_ROWP), 1.0f / (WSC_DN * HSC), (bf16_t*)(ws + WS_FP2)};
                pg8::gemm_phase<pg8::EpiMoeDown, pg8::StaticOrder, false, true, true>(lds, g, S, E, nullptr);
                GRIDBAR();
                if ((int)blockIdx.x < ntail) {
                    pg8::TailSplitOrder S2; S2.S.init(TL[0] - nmain, 2 * (DM / 256), ntail, (int)blockIdx.x, 0); S2.S.pm0 = nmain; S2.kob = DFF / 2;
#pragma unroll
                    for (int e = 0; e < 8; ++e) S2.S.ts[e] = TL[1 + e];
                    pg8::Gemm g2 = g; g2.nt = DFF / 128 / 2;
                    pg8::gemm_phase<pg8::EpiMoeDown, pg8::TailSplitOrder, false, true, true>(lds, g2, S2, E, nullptr);
                } else final_phase(a, G - ntail, (int)blockIdx.x - ntail, 0);
                } SEAM(pb + 7);
            }
        }
        }
    { constexpr int l = 1;
        const int pb = 1 + 8 * l;
        const float* modl = MOD + (size_t)l * 3 * 12288;
        if (IN(pb + 0)) { PHASE_REP(pb + 0) { norm_phase<false, true>(a, lds, G, a.in[I_NMIX] + l * DM, modl, 0, 1, l == 0, nullptr, l == 1 ? (const unsigned short*)(ws + WS_PART) : nullptr, MOD + 2 * 12288 + 5 * DM, 14, false); __syncthreads(); quant_w_in(a, lds, G, l); } SEAM(pb + 0); }
        if (IN(pb + 1)) { PHASE_REP(pb + 1) {
            pg8::Gemm g{XN, (const bf16_t*)(ws + WS_WIN + (size_t)l * SZ_WIN), DM / 2, 0, DM / 128};
            pg8::StaticOrder S; S.init(NPAN, DIN / 256, G, (int)blockIdx.x, 0);
            pg8::EpiProjI8 E{PROJ, (const f32x2*)(ws + WS_ROPE), (const float*)(ws + WS_ROWSC), (const float*)(ws + WS_COLSC_IN) + l * DIN};
            pg8::gemm_phase<pg8::EpiProjI8, pg8::StaticOrder, false, true>(lds, g, S, E, nullptr);
            } SEAM(pb + 1);
        }
        if (IN(pb + 2)) { PHASE_REP(pb + 2) {
            const float* sink = a.in[I_SINK] + l * 8; const float* rpb = a.in[I_RPB] + (size_t)l * 8 * 465; const float* convw = a.in[I_CONVW] + l * 3 * 512;
            { const bool sw = (G == 256); const int xcd = (int)blockIdx.x & 7, w = (int)blockIdx.x >> 3;
              for (int j = 0, i = blockIdx.x; i < 1024; ++j, i += G) { const int b_ = sw ? xcd >> 2 : i >> 9, kh_ = sw ? (xcd >> 1) & 1 : (i >> 8) & 1, q_ = sw ? (xcd & 1) * 128 + j * 32 + w : i & 255;
                  att::swa_unit(PROJ, CAT, sink, (LAS char*)lds, b_, kh_, q_, 0); }
              for (int j = 0, i = blockIdx.x; i < 1024; ++j, i += G) { const int b_ = sw ? xcd >> 2 : i >> 9, hp_ = sw ? xcd & 3 : (i >> 7) & 3, r_ = sw ? j * 32 + w : i & 127;
                  att::na_unit(PROJ, CAT, rpb, (LAS char*)lds, b_, hp_, r_, 0); } }
            if (l == 0) {
                for (int i = G - 1 - (int)blockIdx.x; i < 32; i += G) att::na_unit(PROJ, CAT, rpb, (LAS char*)lds, i >> 4, (i >> 2) & 3, -1, i & 3);
                for (int i = ((G - 33 - (int)blockIdx.x) % G + G) % G; i < 32; i += G) att::swa_unit(PROJ, CAT, sink, (LAS char*)lds, i >> 4, (i >> 3) & 1, -1, i & 7);
                for (int k = 0; k * G < MROWS / 64; ++k) { const int u = k * G + (((int)blockIdx.x - 64 * k) % G + G) % G; if (u < MROWS / 64) att::pc_unit(PROJ, CAT, convw, u); }
            } else {
                for (int i = blockIdx.x; i < NTOK / 64; i += G) att::pc_unit(PROJ, CAT, convw, (i >> 7) * 132 + 4 + (i & 127));
            }
            }
            SEAM(pb + 2);
        }
        if (IN(pb + 3)) { PHASE_REP(pb + 3) {
            pg8::Gemm g{CAT, (const bf16_t*)(ws + WS_WOUT + (size_t)l * SZ_WOUT), DM, 0, DM / 64};
            pg8::StaticOrder S; S.init(NPAN - 2, DM / 256, G, (int)blockIdx.x, 1);
            pg8::EpiResid E{X, a.in[I_X], a.in[I_CTX], modl + 2 * DM, l == 0 ? 1 : 0, rep_ ? (unsigned short*)(ws + WS_END) : X};
            pg8::gemm_phase<pg8::EpiResid, pg8::StaticOrder, false, true>(lds, g, S, E, nullptr);
            if (l == 0) {
                pg8::Gemm g2{CAT, (const bf16_t*)(ws + WS_WOUT), DM, 0, 8};
                pg8::CtxSplitOrder<4> S2{G, (int)blockIdx.x, 8 * 64 * 2};
                pg8::EpiPart E2{(unsigned short*)(ws + WS_PART)};
                pg8::gemm_phase<pg8::EpiPart, pg8::CtxSplitOrder<4>, false, true>(lds, g2, S2, E2, nullptr);
            }
            } SEAM(pb + 3);
        }
        if (l == 0) {
            if (IN(pb + 4)) { PHASE_REP(pb + 4) { norm_phase<false, true>(a, lds, G, a.in[I_NFFN], modl, 3, 4, false, nullptr, (const unsigned short*)(ws + WS_PART), MOD + 2 * 12288 + 2 * DM, 4, true); __syncthreads(); quant_dense_up(a, lds, G); } SEAM(pb + 4); }
            if (IN(pb + 6)) { PHASE_REP(pb + 6) {
                pg8::Gemm g{XN, (const bf16_t*)(ws + WS_WGU), DM / 2, 0, DM / 128};
                pg8::StaticOrder S; S.init(NPAN, NGU / 256, G, (int)blockIdx.x, 0);
                pg8::EpiSwigluI8 E{HID, (const float*)(ws + WS_ROWSC), (const float*)(ws + WS_COLSC)};
                pg8::gemm_phase<pg8::EpiSwigluI8, pg8::StaticOrder, false, true>(lds, g, S, E, nullptr);

                } SEAM(pb + 6);
            }
            if (IN(pb + 7)) { PHASE_REP(pb + 7) {
                pg8::Gemm g{HID, (const bf16_t*)(ws + WS_WD), DFF, 0, DFF / 64};
                pg8::StaticOrder S; S.init(NPAN - 2, DM / 256, G, (int)blockIdx.x, 1); S.wgm = 4;
                pg8::EpiResid E{X, a.in[I_X], a.in[I_CTX], modl + 5 * DM, 0, rep_ ? (unsigned short*)(ws + WS_END) : X};
                pg8::gemm_phase<pg8::EpiResid, pg8::StaticOrder, false, true, false, true>(lds, g, S, E, nullptr);
                pg8::Gemm g2{HID, (const bf16_t*)(ws + WS_WD), DFF, 0, 8};
                pg8::CtxSplitOrder<14> S2{G, (int)blockIdx.x, 8 * 256 * 64 * 2};
                pg8::EpiPart E2{(unsigned short*)(ws + WS_PART)};
                pg8::gemm_phase<pg8::EpiPart, pg8::CtxSplitOrder<14>, false, true, false, true>(lds, g2, S2, E2, nullptr);
                } SEAM(pb + 7);
            }
        } else {
            if (IN(pb + 4)) { PHASE_REP(pb + 4) { norm_phase<true>(a, lds, G, a.in[I_NFFN] + DM, modl, 3, 4, false, a.in[I_ROUTER], nullptr, nullptr, 0, false); } SEAM(pb + 4); }
            if (IN(pb + 5)) { slot_phase(a, lds, G); SEAM(pb + 5); }
            if (IN(pb + 6)) { PHASE_REP(pb + 6) {
                const int* TL = (const int*)(ws + WS_TILES);
                pg8::Gemm g{XN, (const bf16_t*)(ws + WS_WGU + SZ_WGU), DM / 2, SZ_WGU8, DM / 128};
                pg8::StaticOrder S; S.init(TL[0], NGU / 256, G, (int)blockIdx.x, 0);
#pragma unroll
                for (int e = 0; e < 8; ++e) S.ts[e] = TL[1 + e];
                pg8::EpiSwiglu8 E{(unsigned char*)HID, 1.0f / WSC_UP, HSC};
                pg8::gemm_phase<pg8::EpiSwiglu8, pg8::StaticOrder, true, true, true>(lds, g, S, E, (const int*)(ws + WS_ROWTOK));
                } SEAM(pb + 6);
            }
            if (IN(pb + 7)) { PHASE_REP(pb + 7) {
                const int* TL = (const int*)(ws + WS_TILES);
                pg8::Gemm g{HID, (const bf16_t*)(ws + WS_WD + SZ_WD), DFF / 2, SZ_WD8, DFF / 128};
                const int nmain = TL[0] < 128 ? TL[0] : 128, ntail = (TL[0] - nmain) * (DM / 256) * 2;
                pg8::StaticOrder S; S.init(nmain, DM / 256, G, (int)blockIdx.x, 0); S.wgm = 4;
#pragma unroll
                for (int e = 0; e < 8; ++e) S.ts[e] = TL[1 + e];
                pg8::EpiMoeDown E{FP, (const int*)(ws + WS_ROWDST), (const float*)(ws + WS_ROWP), 1.0f / (WSC_DN * HSC), (bf16_t*)(ws + WS_FP2)};
                pg8::gemm_phase<pg8::EpiMoeDown, pg8::StaticOrder, false, true, true>(lds, g, S, E, nullptr);
                GRIDBAR();
                if ((int)blockIdx.x < ntail) {
                    pg8::TailSplitOrder S2; S2.S.init(TL[0] - nmain, 2 * (DM / 256), ntail, (int)blockIdx.x, 0); S2.S.pm0 = nmain; S2.kob = DFF / 2;
#pragma unroll
                    for (int e = 0; e < 8; ++e) S2.S.ts[e] = TL[1 + e];
                    pg8::Gemm g2 = g; g2.nt = DFF / 128 / 2;
                    pg8::gemm_phase<pg8::EpiMoeDown, pg8::TailSplitOrder, false, true, true>(lds, g2, S2, E, nullptr);
                } else final_phase(a, G - ntail, (int)blockIdx.x - ntail, 0);
                } SEAM(pb + 7);
            }
        }
        }
    if (IN(17)) { PHASE_REP(17) { final_phase(a, G, (int)blockIdx.x, 1); } }
#undef IN
#undef SEAM
#undef GRIDBAR
}

extern "C" void kernel_launch(void* const* d_in, const int* in_sizes, int n_in, void* d_out, int out_size, void* d_ws, size_t ws_size, hipStream_t stream) {
    static int grid = 0;
    if (grid == 0) {
        if (n_in != 23 || in_sizes[0] != NB * SEQ * DM || out_size != NB * SEQ * DM || ws_size < WS_END) {
            fprintf(stderr, "kernel_launch: unexpected shapes: n_in %d in0 %d out %d ws %zu (need %zu); nothing launched\n", n_in, n_in > 0 ? in_sizes[0] : -1, out_size, ws_size, (size_t)WS_END); grid = -1; return; }
        int dev = 0, cus = 0, per_cu = 0;
        if (hipGetDevice(&dev) != hipSuccess || hipDeviceGetAttribute(&cus, hipDeviceAttributeMultiprocessorCount, dev) != hipSuccess) { grid = -1; return; }
        if (hipFuncSetAttribute((const void*)mk_fwd, hipFuncAttributeMaxDynamicSharedMemorySize, LDS_BYTES) != hipSuccess) { fprintf(stderr, "kernel_launch: hipFuncSetAttribute failed\n"); grid = -1; return; }
        if (hipOccupancyMaxActiveBlocksPerMultiprocessor(&per_cu, (const void*)mk_fwd, NWAVES * 64, LDS_BYTES) != hipSuccess || per_cu < 1)
            fprintf(stderr, "kernel_launch: note: occupancy query reports %d workgroups per CU\n", per_cu);
        (void)hipGetLastError();
        grid = cus;
    }
    if (grid < 0) return;
    if (hipMemsetAsync((char*)d_ws + WS_CTL, 0, CTL_ZERO_BYTES, stream) != hipSuccess) return;
    Args a{};
    for (int i = 0; i < 23; ++i) a.in[i] = (const float*)d_in[i];
    a.out = (float*)d_out; a.ws = (unsigned char*)d_ws;
#if MK_PER_PHASE
    for (int p = 0; p < N_PHASES; ++p) { if (p == 6) continue; a.ph_lo = p; a.ph_hi = p + 1; hipLaunchKernelGGL(mk_fwd, dim3(grid), dim3(NWAVES * 64), LDS_BYTES, stream, a); }
#else
    a.ph_lo = 0; a.ph_hi = N_PHASES;
    hipLaunchKernelGGL(mk_fwd, dim3(grid), dim3(NWAVES * 64), LDS_BYTES, stream, a);
#endif
    const hipError_t le = hipPeekAtLastError();
    if (le != hipSuccess) fprintf(stderr, "kernel_launch: launch failed: %s\n", hipGetErrorName(le));
}
```
